# Optimizing an MI355X kernel written in HIP

```python
import jax
import jax.numpy as jnp
from jax import lax
import numpy as np

D_MODEL = 2048
BATCH = 8
SEQ = 2048
DEPTH = 2

CTX_LEN = 256
GRID_W = 64
EPS = 1e-6
ROPE_BASE = 10000.0
Q_BLOCK = 128

ML_HEADS = 4
ML_DIM = 128
ML_CHUNK = 64
ML_W = ML_HEADS * ML_DIM

GQA_HEADS = 8
GQA_KV = 2
GQA_GROUP = GQA_HEADS // GQA_KV
GQA_DIM = 128
GQA_QW = GQA_HEADS * GQA_DIM
GQA_KW = GQA_KV * GQA_DIM

MLA_HEADS = 4
MLA_Q_RANK = 512
MLA_KV_RANK = 256
MLA_NOPE = 128
MLA_ROPE = 64
MLA_QK = MLA_NOPE + MLA_ROPE
MLA_V = 128
MLA_W = MLA_HEADS * MLA_V

MIX_W = ML_W + GQA_QW + MLA_W
SPLIT_SIZES = (ML_W, ML_W, ML_W, ML_W, 4 * ML_HEADS, GQA_QW, GQA_KW, GQA_KW, MLA_Q_RANK, MLA_KV_RANK, MLA_ROPE)
IN_W = ML_W * 4 + 4 * ML_HEADS + GQA_QW + 2 * GQA_KW + MLA_Q_RANK + MLA_KV_RANK + MLA_ROPE

N_EXPERTS = 16
EXPERT_FF = 2048
EC_CAPACITY = 2

kernel_name = "hybrid_mlstm_gqa_mla_ecmoe_dit"


def rms_norm(x, g):
    xf = x.astype(jnp.float32)
    y = xf * lax.rsqrt(jnp.mean(xf * xf, axis=-1, keepdims=True) + EPS)
    return (y * g.astype(jnp.float32)).astype(x.dtype)


def modulate(x, g, shift, scale):
    return rms_norm(x, g) * (1 + scale) + shift


def axial_rope(row, col, rot_dim):
    quarter = rot_dim // 4
    inv = ROPE_BASE ** (-jnp.arange(quarter, dtype=jnp.float32) / quarter)
    ang = jnp.concatenate([row.astype(jnp.float32)[:, None] * inv,
                           col.astype(jnp.float32)[:, None] * inv], axis=-1)
    return jnp.cos(ang), jnp.sin(ang)


def apply_rope(x, cos, sin):
    half = x.shape[-1] // 2
    xf = x.astype(jnp.float32)
    x1, x2 = xf[..., :half], xf[..., half:]
    c, s = cos[:, None, :], sin[:, None, :]
    return jnp.concatenate([x1 * c - x2 * s, x2 * c + x1 * s], axis=-1).astype(x.dtype)


def split_cols(p):
    idx = []
    acc = 0
    for s in SPLIT_SIZES[:-1]:
        acc += s
        idx.append(acc)
    return jnp.split(p, idx, axis=-1)


def attend_blocks(q, k, v, scale):
    b, kh, g, n, dq = q.shape
    nb = n // Q_BLOCK
    qb = jnp.moveaxis(q.reshape(b, kh, g, nb, Q_BLOCK, dq), 3, 0)

    def one(qi):
        s = jnp.einsum('bkgqd,bkmd->bkgqm', qi, k).astype(jnp.float32) * scale
        p = jax.nn.softmax(s, axis=-1).astype(v.dtype)
        return jnp.einsum('bkgqm,bkmd->bkgqd', p, v)

    o = lax.map(one, qb)
    return jnp.moveaxis(o, 0, 3).reshape(b, kh, g, n, v.shape[-1])


def merge_heads(o):
    b, kh, g, n, d = o.shape
    return o.transpose(0, 3, 1, 2, 4).reshape(b, n, kh * g * d)


def mlstm_scan(q, k, v, logi, logf, state):
    b, h, n, d = q.shape
    nc = n // ML_CHUNK

    def to_chunks(a):
        return jnp.moveaxis(a.reshape((b, h, nc, ML_CHUNK) + a.shape[3:]), 2, 0)

    xs = (to_chunks(q), to_chunks(k), to_chunks(v), to_chunks(logi), to_chunks(logf))
    tri = jnp.tril(jnp.ones((ML_CHUNK, ML_CHUNK), dtype=bool))

    def step(carry, inp):
        cmat, nvec, m = carry
        qc, kc, vc, ic, fc = inp
        bcum = jnp.cumsum(fc, axis=-1)
        dmat = jnp.where(tri, bcum[..., :, None] - bcum[..., None, :] + ic[..., None, :], -jnp.inf)
        g = bcum + m[..., None]
        m_t = jnp.maximum(g, jnp.max(dmat, axis=-1))
        w_intra = jnp.exp(dmat - m_t[..., None])
        w_inter = jnp.exp(g - m_t)
        qk = jnp.einsum('bhtd,bhsd->bhts', qc, kc) * w_intra
        num = w_inter[..., None] * jnp.einsum('bhtd,bhde->bhte', qc, cmat) + jnp.einsum('bhts,bhse->bhte', qk, vc)
        den = w_inter * jnp.einsum('bhtd,bhd->bht', qc, nvec) + jnp.sum(qk, axis=-1)
        hc = num / jnp.maximum(jnp.abs(den), jnp.exp(-m_t))[..., None]
        btot = bcum[..., -1]
        a = btot[..., None] - bcum + ic
        m_new = jnp.maximum(btot + m, jnp.max(a, axis=-1))
        ws = jnp.exp(a - m_new[..., None])
        wc = jnp.exp(btot + m - m_new)
        c_new = wc[..., None, None] * cmat + jnp.einsum('bhs,bhsd,bhse->bhde', ws, kc, vc)
        n_new = wc[..., None] * nvec + jnp.einsum('bhs,bhsd->bhd', ws, kc)
        return (c_new, n_new, m_new), hc

    state, hs = lax.scan(step, state, xs)
    return jnp.moveaxis(hs, 0, 2).reshape(b, h, n, d), state


def mlstm_inputs(parts, b_gates):
    q, k, v, _, gates = parts
    b, n, _ = q.shape

    def heads(a):
        return a.reshape(b, n, ML_HEADS, ML_DIM).transpose(0, 2, 1, 3).astype(jnp.float32)

    g = (gates + b_gates).astype(jnp.float32).reshape(b, n, 4, ML_HEADS).transpose(2, 0, 3, 1)
    fwd = (g[0], jax.nn.log_sigmoid(g[1]))
    bwd = (g[2], jax.nn.log_sigmoid(g[3]))
    return heads(q), heads(k) * (ML_DIM ** -0.5), heads(v), fwd, bwd


def mlstm_out(h, o, ml_norm):
    b, _, n, _ = h.shape
    h = rms_norm(h.transpose(0, 2, 1, 3), ml_norm.reshape(ML_HEADS, ML_DIM)).reshape(b, n, ML_W)
    return (h * jax.nn.sigmoid(o.astype(jnp.float32))).astype(o.dtype)


def mlstm_group(lat_parts, ctx_parts, b_gates, ml_norm, need_ctx):
    ql, kl, vl, fl, bl = mlstm_inputs(lat_parts, b_gates)
    qc, kc, vc, fc, bc = mlstm_inputs(ctx_parts, b_gates)
    b = ql.shape[0]
    zero = (jnp.zeros((b, ML_HEADS, ML_DIM, ML_DIM), jnp.float32),
            jnp.zeros((b, ML_HEADS, ML_DIM), jnp.float32),
            jnp.zeros((b, ML_HEADS), jnp.float32))

    def flip(a):
        return jnp.flip(a, axis=2)

    h_cf, st_f = mlstm_scan(qc, kc, vc, fc[0], fc[1], zero)
    h_lf, _ = mlstm_scan(ql, kl, vl, fl[0], fl[1], st_f)
    h_cb, st_b = mlstm_scan(flip(qc), flip(kc), flip(vc), flip(bc[0]), flip(bc[1]), zero)
    h_lb, _ = mlstm_scan(flip(ql), flip(kl), flip(vl), flip(bl[0]), flip(bl[1]), st_b)
    out_l = mlstm_out(h_lf + flip(h_lb), lat_parts[3], ml_norm)
    out_c = mlstm_out(h_cf + flip(h_cb), ctx_parts[3], ml_norm) if need_ctx else None
    return out_l, out_c


def gqa_prep(q, k, v, q_norm, k_norm, rope):
    b, n, _ = q.shape
    q = rms_norm(q.reshape(b, n, GQA_HEADS, GQA_DIM), q_norm)
    k = rms_norm(k.reshape(b, n, GQA_KV, GQA_DIM), k_norm)
    if rope is not None:
        q = apply_rope(q, rope[0], rope[1])
        k = apply_rope(k, rope[0], rope[1])
    q = q.reshape(b, n, GQA_KV, GQA_GROUP, GQA_DIM).transpose(0, 2, 3, 1, 4)
    k = k.transpose(0, 2, 1, 3)
    v = v.reshape(b, n, GQA_KV, GQA_DIM).transpose(0, 2, 1, 3)
    return q, k, v


def gqa_group(lat_parts, ctx_parts, q_norm, k_norm, rope, need_ctx):
    scale = GQA_DIM ** -0.5
    ql, kl, vl = gqa_prep(lat_parts[0], lat_parts[1], lat_parts[2], q_norm, k_norm, rope)
    qc, kc, vc = gqa_prep(ctx_parts[0], ctx_parts[1], ctx_parts[2], q_norm, k_norm, None)
    k_all = jnp.concatenate([kc, kl], axis=2)
    v_all = jnp.concatenate([vc, vl], axis=2)
    out_l = merge_heads(attend_blocks(ql, k_all, v_all, scale))
    out_c = merge_heads(attend_blocks(qc, kc, vc, scale)) if need_ctx else None
    return out_l, out_c


def mla_prep(parts, qa_norm, kva_norm, w_uq, w_ukv, q_norm, k_norm, rope):
    q_a, kv_a, k_rope = parts
    b, n, _ = q_a.shape
    q = (rms_norm(q_a, qa_norm) @ w_uq).reshape(b, n, MLA_HEADS, MLA_QK)
    kv = (rms_norm(kv_a, kva_norm) @ w_ukv).reshape(b, n, MLA_HEADS, MLA_NOPE + MLA_V)
    k_nope, v = kv[..., :MLA_NOPE], kv[..., MLA_NOPE:]
    k = jnp.concatenate([k_nope, jnp.broadcast_to(k_rope[:, :, None, :], (b, n, MLA_HEADS, MLA_ROPE))], axis=-1)
    q = rms_norm(q, q_norm)
    k = rms_norm(k, k_norm)
    if rope is not None:
        q = jnp.concatenate([q[..., :MLA_NOPE], apply_rope(q[..., MLA_NOPE:], rope[0], rope[1])], axis=-1)
        k = jnp.concatenate([k[..., :MLA_NOPE], apply_rope(k[..., MLA_NOPE:], rope[0], rope[1])], axis=-1)
    q = q.transpose(0, 2, 1, 3)[:, :, None]
    return q, k.transpose(0, 2, 1, 3), v.transpose(0, 2, 1, 3)


def mla_group(lat_parts, ctx_parts, qa_norm, kva_norm, w_uq, w_ukv, q_norm, k_norm, rope, need_ctx):
    scale = MLA_QK ** -0.5
    ql, kl, vl = mla_prep(lat_parts, qa_norm, kva_norm, w_uq, w_ukv, q_norm, k_norm, rope)
    qc, kc, vc = mla_prep(ctx_parts, qa_norm, kva_norm, w_uq, w_ukv, q_norm, k_norm, None)
    k_all = jnp.concatenate([kc, kl], axis=2)
    v_all = jnp.concatenate([vc, vl], axis=2)
    out_l = merge_heads(attend_blocks(ql, k_all, v_all, scale))
    out_c = merge_heads(attend_blocks(qc, kc, vc, scale)) if need_ctx else None
    return out_l, out_c


def hybrid_mixer(h, hc, w_in, b_gates, ml_norm, gqa_q_norm, gqa_k_norm, mla_qa_norm, mla_kva_norm,
                 mla_w_uq, mla_w_ukv, mla_q_norm, mla_k_norm, rope_g, rope_m, need_ctx):
    pl = split_cols(h @ w_in)
    pc = split_cols(hc @ w_in)
    a_l, a_c = mlstm_group(pl[0:5], pc[0:5], b_gates, ml_norm, need_ctx)
    g_l, g_c = gqa_group(pl[5:8], pc[5:8], gqa_q_norm, gqa_k_norm, rope_g, need_ctx)
    m_l, m_c = mla_group(pl[8:11], pc[8:11], mla_qa_norm, mla_kva_norm, mla_w_uq, mla_w_ukv,
                         mla_q_norm, mla_k_norm, rope_m, need_ctx)
    out_l = jnp.concatenate([a_l, g_l, m_l], axis=-1)
    out_c = jnp.concatenate([a_c, g_c, m_c], axis=-1) if need_ctx else None
    return out_l, out_c


def expert_choice_ffn(h, w_router, w_gate, w_up, w_down):
    b, n, _ = h.shape
    cap = EC_CAPACITY * n // N_EXPERTS
    aff = jax.nn.softmax((h @ w_router).astype(jnp.float32), axis=-1)
    gval, idx = lax.top_k(jnp.swapaxes(aff, 1, 2), cap)
    bidx = jnp.arange(b)[:, None, None]
    xe = h[bidx, idx]
    a = jnp.einsum('becd,edf->becf', xe, w_gate)
    u = jnp.einsum('becd,edf->becf', xe, w_up)
    y = jnp.einsum('becf,efd->becd', jax.nn.silu(a) * u, w_down)
    y = y * gval[..., None].astype(y.dtype)
    return jnp.zeros_like(h).at[bidx, idx].add(y)


def setup_inputs(seed: int = 0) -> dict:
    key = jax.random.key(seed)
    ks = jax.random.split(key, 24)
    L, D = DEPTH, D_MODEL

    def nrm(k, shape, s):
        return jax.random.normal(k, shape, jnp.float32) * s

    def gain(k, shape):
        return 1.0 + 0.02 * jax.random.normal(k, shape, jnp.float32)

    gate_base = jnp.concatenate([jnp.zeros((ML_HEADS,), jnp.float32), jnp.linspace(3.0, 6.0, ML_HEADS, dtype=jnp.float32),
                                 jnp.zeros((ML_HEADS,), jnp.float32), jnp.linspace(3.0, 6.0, ML_HEADS, dtype=jnp.float32)])
    return {
        "x": nrm(ks[0], (BATCH, SEQ, D), 1.0),
        "c": nrm(ks[1], (BATCH, D), 1.0),
        "ctx": nrm(ks[2], (BATCH, CTX_LEN, D), 1.0),
        "c_ctx": nrm(ks[3], (D,), 1.0),
        "ada_w": nrm(ks[4], (L, D, 6 * D), 0.5 * D ** -0.5),
        "ada_b": nrm(ks[5], (L, 6 * D), 0.02),
        "norm1": gain(ks[6], (L, D)),
        "norm2": gain(ks[7], (L, D)),
        "w_in": nrm(ks[8], (L, D, IN_W), D ** -0.5),
        "b_gates": gate_base + nrm(ks[9], (L, 4 * ML_HEADS), 0.1),
        "ml_norm": gain(ks[10], (L, ML_W)),
        "gqa_q_norm": gain(ks[11], (L, GQA_DIM)),
        "gqa_k_norm": gain(ks[12], (L, GQA_DIM)),
        "mla_qa_norm": gain(ks[13], (L, MLA_Q_RANK)),
        "mla_kva_norm": gain(ks[14], (L, MLA_KV_RANK)),
        "mla_w_uq": nrm(ks[15], (L, MLA_Q_RANK, MLA_HEADS * MLA_QK), MLA_Q_RANK ** -0.5),
        "mla_w_ukv": nrm(ks[16], (L, MLA_KV_RANK, MLA_HEADS * (MLA_NOPE + MLA_V)), MLA_KV_RANK ** -0.5),
        "mla_q_norm": gain(ks[17], (L, MLA_QK)),
        "mla_k_norm": gain(ks[18], (L, MLA_QK)),
        "w_out": nrm(ks[19], (L, MIX_W, D), MIX_W ** -0.5),
        "w_router": nrm(ks[20], (L, D, N_EXPERTS), D ** -0.5),
        "w_gate": nrm(ks[21], (L, N_EXPERTS, D, EXPERT_FF), D ** -0.5),
        "w_up": nrm(ks[22], (L, N_EXPERTS, D, EXPERT_FF), D ** -0.5),
        "w_down": nrm(ks[23], (L, N_EXPERTS, EXPERT_FF, D), EXPERT_FF ** -0.5),
    }


def reference(x, c, ctx, c_ctx, ada_w, ada_b, norm1, norm2, w_in, b_gates, ml_norm, gqa_q_norm, gqa_k_norm,
              mla_qa_norm, mla_kva_norm, mla_w_uq, mla_w_ukv, mla_q_norm, mla_k_norm, w_out,
              w_router, w_gate, w_up, w_down):
    n_lat = x.shape[1]
    rows = n_lat // GRID_W
    row = jnp.repeat(jnp.arange(rows), GRID_W)
    col = jnp.tile(jnp.arange(GRID_W), rows)
    rope_g = axial_rope(row, col, GQA_DIM)
    rope_m = axial_rope(row, col, MLA_ROPE)
    s_c = jax.nn.silu(c)
    s_cc = jax.nn.silu(c_ctx)
    for l in range(DEPTH):
        last = l == DEPTH - 1
        mod = (s_c @ ada_w[l] + ada_b[l])[:, None, :]
        mod_c = s_cc @ ada_w[l] + ada_b[l]
        sh1, sc1, g1, sh2, sc2, g2 = jnp.split(mod, 6, axis=-1)
        csh1, csc1, cg1, csh2, csc2, cg2 = jnp.split(mod_c, 6, axis=-1)
        h = modulate(x, norm1[l], sh1, sc1)
        hc = modulate(ctx, norm1[l], csh1, csc1)
        mix_l, mix_c = hybrid_mixer(h, hc, w_in[l], b_gates[l], ml_norm[l], gqa_q_norm[l], gqa_k_norm[l],
                                    mla_qa_norm[l], mla_kva_norm[l], mla_w_uq[l], mla_w_ukv[l],
                                    mla_q_norm[l], mla_k_norm[l], rope_g, rope_m, not last)
        x = x + g1 * (mix_l @ w_out[l])
        x = x + g2 * expert_choice_ffn(modulate(x, norm2[l], sh2, sc2), w_router[l], w_gate[l], w_up[l], w_down[l])
        if not last:
            ctx = ctx + cg1 * (mix_c @ w_out[l])
            ctx = ctx + cg2 * expert_choice_ffn(modulate(ctx, norm2[l], csh2, csc2), w_router[l], w_gate[l], w_up[l], w_down[l])
    return x
```

```cpp
#include <hip/hip_runtime.h>
#include <cstdio>
#include <cstdint>
namespace pg8 {
#define PG8_LAS __attribute__((address_space(3)))
typedef unsigned short bf16_t;
typedef short bf16x8 __attribute__((ext_vector_type(8)));
typedef float f32x4 __attribute__((ext_vector_type(4)));
typedef unsigned u32x4 __attribute__((ext_vector_type(4)));
constexpr int BM = 256, BK = 64, HALF = 128, HTB = HALF * BK * 2  , STAGE_BYTES = 8 * HTB, NXCD = 8, WGM = 8;

__host__ __device__ __forceinline__ int lds_byte(int r, int c) { const int st = (r >> 4) * 2 + (c >> 5), rr = r & 15, cc = c & 31, ob = rr * 64 + cc * 2; return st * 1024 + (ob ^ (((ob >> 9) & 1) << 5)); }
__host__ __device__ __forceinline__ void stage_rc(int b, int& R, int& C) { const int st = b / 1024, sb = b % 1024, swz = sb ^ (((sb >> 9) & 1) << 5); R = (st >> 1) * 16 + swz / 64; C = (st & 1) * 32 + (swz % 64) / 2; }
__host__ __device__ __forceinline__ int perm32(int rho) { const int n = rho >> 4, i = rho & 15; return 8 * (i >> 2) + 4 * n + (i & 3); }

struct Unit { int pm, pn; };
struct Gemm { const bf16_t* A; const bf16_t* Bt; int M, N, K; const int* aidx; };
__device__ __forceinline__ unsigned cvt_pk_bf16(float lo, float hi) { unsigned r; asm volatile("v_cvt_pk_bf16_f32 %0, %1, %2" : "=v"(r) : "v"(lo), "v"(hi)); return r; }
template <class Epi, class Sched, bool ALIGN_EPI = false, bool SP2 = false, bool GATHER = false, int BAUX = 0>
__device__ __forceinline__ void gemm_phase(PG8_LAS unsigned char* lds, const Gemm g, const Sched& S, const Epi& E) {
    int tid_ = threadIdx.x; asm volatile("" : "+v"(tid_));
    const int tid = tid_, wid = __builtin_amdgcn_readfirstlane(tid >> 6), lane = tid & 63, wr = wid >> 2, wc = wid & 3, fr = lane & 15, fq = lane >> 4;
    const int K = g.K, nt = K / BK;
    unsigned voffA[2], voffB[2];
#pragma unroll
    for (int i = 0; i < 2; ++i) { int R, C; stage_rc(tid * 16 + i * 8192, R, C); const int Rb = Epi::PERM ? ((R & ~31) + perm32(R & 31)) : R;
        voffA[i] = (unsigned)(R * K + C) * 2u; voffB[i] = (unsigned)(Rb * K + C) * 2u; }
    static_assert(!GATHER || SP2, "GATHER is implemented for the SP2 loop only");
    unsigned gAc[2][2], gAn[2][2]; int gR[2], gC[2];
    PG8_LAS int* gtbl = (PG8_LAS int*)(lds + STAGE_BYTES);
    if constexpr (GATHER) {
#pragma unroll
        for (int i = 0; i < 2; ++i) stage_rc(tid * 16 + i * 8192, gR[i], gC[i]);
        Unit uu;
        for (int i = 0; i < 10 && S.next(i, uu); ++i) if (tid < 256) gtbl[i * 256 + tid] = g.aidx[uu.pm * BM + tid];
        __syncthreads();
#pragma unroll
        for (int h = 0; h < 2; ++h)
#pragma unroll
            for (int i = 0; i < 2; ++i) gAc[h][i] = (unsigned)gtbl[h * HALF + gR[i]] * (unsigned)(K * 2) + (unsigned)(gC[i] * 2);
    }
#define PG8_STAGE_A(bufoff, kptr, h, usenext) do { if constexpr (GATHER) { _Pragma("unroll") for (int _i = 0; _i < 2; ++_i) \
        __builtin_amdgcn_global_load_lds((const unsigned*)((const char*)(kptr) + ((usenext) ? gAn[h][_i] : gAc[h][_i])), (PG8_LAS unsigned*)(lds + (bufoff) + ldsw + _i * 8192), 16, 0, 0); } \
        else { PG8_STAGE(bufoff, (kptr) + (h) * hstep, voffA); } } while (0)
    const size_t kstep = (size_t)(BK * 2);
    const size_t hstep = (size_t)HALF * K * 2;
    const size_t tstep = 2 * hstep;
    const unsigned ldsw = (unsigned)wid * 1024u;
    const int aoff = lds_byte(wr * 64 + fr, fq * 8), boff = lds_byte(wc * 32 + fr, fq * 8);
#define PG8_SA(b, h) (((b) * 2 + (h)) * HTB)
#define PG8_SB(b, h) ((4 + (b) * 2 + (h)) * HTB)
#define PG8_STAGE(bufoff, gbase, voff) do { _Pragma("unroll") for (int _i = 0; _i < 2; ++_i) \
        __builtin_amdgcn_global_load_lds((const unsigned*)((const char*)(gbase) + (voff)[_i]), (PG8_LAS unsigned*)(lds + (bufoff) + ldsw + _i * 8192), 16, 0, 0); } while (0)
#define PG8_STAGE_B(bufoff, gbase, voff) do { _Pragma("unroll") for (int _i = 0; _i < 2; ++_i) \
        __builtin_amdgcn_global_load_lds((const unsigned*)((const char*)(gbase) + (voff)[_i]), (PG8_LAS unsigned*)(lds + (bufoff) + ldsw + _i * 8192), 16, 0, BAUX); } while (0)
#define PG8_LDA(dst, b, h) do { _Pragma("unroll") for (int m = 0; m < 4; ++m) _Pragma("unroll") for (int k = 0; k < 2; ++k) dst[m][k] = *(const PG8_LAS bf16x8*)(lds + PG8_SA(b, h) + aoff + m * 2048 + k * 1024); } while (0)
#define PG8_LDB(dst, b, h) do { _Pragma("unroll") for (int n = 0; n < 2; ++n) _Pragma("unroll") for (int k = 0; k < 2; ++k) dst[n][k] = *(const PG8_LAS bf16x8*)(lds + PG8_SB(b, h) + boff + n * 2048 + k * 1024); } while (0)
#define PG8_MMA(ai, bj, At, Bt) do { __builtin_amdgcn_s_setprio(1); _Pragma("unroll") for (int m = 0; m < 4; ++m) _Pragma("unroll") for (int n = 0; n < 2; ++n) _Pragma("unroll") for (int k = 0; k < 2; ++k) \
        acc[ai][bj][m][n] = __builtin_amdgcn_mfma_f32_16x16x32_bf16(Bt[n][k], At[m][k], acc[ai][bj][m][n], 0, 0, 0); __builtin_amdgcn_s_setprio(0); } while (0)
#define PG8_WAIT_V(n) asm volatile("s_waitcnt vmcnt(" #n ")" ::: "memory")
#define PG8_WAIT_L(n) asm volatile("s_waitcnt lgkmcnt(" #n ")" ::: "memory")
#define PG8_BAR __builtin_amdgcn_s_barrier()
#define PG8_SCHED __builtin_amdgcn_sched_barrier(0)
    Unit cur, nxt; int ui = 0;
    if (!S.next(0, cur)) return;
    f32x4 acc[2][2][4][2];
#pragma unroll
    for (int a = 0; a < 2; ++a)
#pragma unroll
        for (int b = 0; b < 2; ++b)
#pragma unroll
            for (int m = 0; m < 4; ++m)
#pragma unroll
                for (int n = 0; n < 2; ++n) acc[a][b][m][n] = (f32x4){0.f, 0.f, 0.f, 0.f};
    bf16x8 At[4][2], B0[2][2], B1[2][2];
    const char* cA = GATHER ? (const char*)g.A : (const char*)g.A + (size_t)cur.pm * tstep; const char* cB = (const char*)g.Bt + (size_t)cur.pn * tstep;
    S.a_ready(cur);
    if constexpr (SP2) {
        PG8_STAGE_B(PG8_SB(0, 0), cB, voffB); PG8_STAGE_B(PG8_SB(0, 1), cB + hstep, voffB); PG8_STAGE_A(PG8_SA(0, 0), cA, 0, false); PG8_STAGE_A(PG8_SA(0, 1), cA, 1, false);
        if (wr == 1) PG8_BAR;
        PG8_WAIT_V(2); PG8_BAR;
        PG8_STAGE_B(PG8_SB(1, 0), cB + kstep, voffB); PG8_STAGE_A(PG8_SA(1, 0), cA + kstep, 0, false); PG8_STAGE_B(PG8_SB(1, 1), cB + hstep + kstep, voffB);
        PG8_WAIT_V(6); PG8_BAR;
    } else {
        PG8_STAGE_B(PG8_SB(0, 0), cB, voffB); PG8_STAGE(PG8_SA(0, 0), cA, voffA); PG8_STAGE_B(PG8_SB(0, 1), cB + hstep, voffB); PG8_STAGE(PG8_SA(0, 1), cA + hstep, voffA);
        if (wr == 1) PG8_BAR;
        PG8_WAIT_V(4); PG8_BAR;
        PG8_STAGE_B(PG8_SB(1, 0), cB + kstep, voffB); PG8_STAGE(PG8_SA(1, 0), cA + kstep, voffA); PG8_STAGE_B(PG8_SB(1, 1), cB + hstep + kstep, voffB);
        PG8_WAIT_V(6); PG8_BAR;
    }
    for (;;) {
        const bool has_next = S.next(ui + 1, nxt);
        const char* nA = (has_next && !GATHER) ? (const char*)g.A + (size_t)nxt.pm * tstep : cA; const char* nB = has_next ? (const char*)g.Bt + (size_t)nxt.pn * tstep : cB;
        if constexpr (GATHER) {
#pragma unroll
            for (int h = 0; h < 2; ++h)
#pragma unroll
                for (int i = 0; i < 2; ++i) gAn[h][i] = has_next ? (unsigned)gtbl[(ui + 1) * 256 + h * HALF + gR[i]] * (unsigned)(K * 2) + (unsigned)(gC[i] * 2) : gAc[h][i];
        }
        for (int t = 0; t < nt; t += 2) {
            const bool last = (t == nt - 2);
            const char* a1 = cA + (size_t)(t + 1) * kstep;
            const char* a2 = last ? nA : cA + (size_t)(t + 2) * kstep; const char* b2 = last ? nB : cB + (size_t)(t + 2) * kstep;
            const char* a3 = a2 + kstep; const char* b3 = b2 + kstep;
            if (last && has_next) S.a_ready(nxt);
            if constexpr (SP2) {
            PG8_LDB(B0, 0, 0); PG8_LDB(B1, 0, 1); PG8_SCHED; PG8_LDA(At, 0, 0); PG8_STAGE_A(PG8_SA(1, 1), a1, 1, false);
            PG8_WAIT_V(8); PG8_WAIT_L(0); PG8_BAR; PG8_MMA(0, 0, At, B0); PG8_MMA(0, 1, At, B1); PG8_BAR; PG8_SCHED;
            PG8_LDA(At, 0, 1); PG8_STAGE_B(PG8_SB(0, 0), b2, voffB); PG8_STAGE_B(PG8_SB(0, 1), b2 + hstep, voffB); PG8_STAGE_A(PG8_SA(0, 0), a2, 0, last);
            PG8_WAIT_V(8); PG8_WAIT_L(0); PG8_BAR; PG8_MMA(1, 0, At, B0); PG8_MMA(1, 1, At, B1); PG8_BAR; PG8_SCHED;
            PG8_LDB(B0, 1, 0); PG8_LDB(B1, 1, 1); PG8_SCHED; PG8_LDA(At, 1, 0); PG8_STAGE_A(PG8_SA(0, 1), a2, 1, last);
            PG8_WAIT_V(8); PG8_WAIT_L(0); PG8_BAR; PG8_MMA(0, 0, At, B0); PG8_MMA(0, 1, At, B1); PG8_BAR; PG8_SCHED;
            PG8_LDA(At, 1, 1); PG8_STAGE_B(PG8_SB(1, 0), b3, voffB); PG8_STAGE_B(PG8_SB(1, 1), b3 + hstep, voffB); PG8_STAGE_A(PG8_SA(1, 0), a3, 0, last);
            PG8_WAIT_V(8); PG8_WAIT_L(0); PG8_BAR; PG8_MMA(1, 0, At, B0); PG8_MMA(1, 1, At, B1); PG8_BAR; PG8_SCHED;
            } else {
            PG8_LDB(B0, 0, 0); PG8_SCHED; PG8_LDA(At, 0, 0); PG8_STAGE(PG8_SA(1, 1), a1 + hstep, voffA);
            PG8_WAIT_L(8); PG8_BAR; PG8_WAIT_L(0); PG8_MMA(0, 0, At, B0); PG8_BAR; PG8_SCHED;
            PG8_LDB(B1, 0, 1); PG8_STAGE_B(PG8_SB(0, 0), b2, voffB);
            PG8_BAR; PG8_WAIT_L(0); PG8_MMA(0, 1, At, B1); PG8_BAR;
            PG8_LDA(At, 0, 1); PG8_STAGE(PG8_SA(0, 0), a2, voffA);
            PG8_BAR; PG8_WAIT_L(0); PG8_MMA(1, 0, At, B0); PG8_BAR; PG8_SCHED;
            PG8_STAGE_B(PG8_SB(0, 1), b2 + hstep, voffB);
            PG8_WAIT_V(6); PG8_BAR; PG8_MMA(1, 1, At, B1); PG8_BAR;
            PG8_LDB(B0, 1, 0); PG8_SCHED; PG8_LDA(At, 1, 0); PG8_STAGE(PG8_SA(0, 1), a2 + hstep, voffA);
            PG8_WAIT_L(8); PG8_BAR; PG8_WAIT_L(0); PG8_MMA(0, 0, At, B0); PG8_BAR; PG8_SCHED;
            PG8_LDB(B1, 1, 1); PG8_STAGE_B(PG8_SB(1, 0), b3, voffB);
            PG8_BAR; PG8_WAIT_L(0); PG8_MMA(0, 1, At, B1); PG8_BAR;
            PG8_LDA(At, 1, 1); PG8_STAGE(PG8_SA(1, 0), a3, voffA);
            PG8_BAR; PG8_WAIT_L(0); PG8_MMA(1, 0, At, B0); PG8_BAR; PG8_SCHED;
            PG8_STAGE_B(PG8_SB(1, 1), b3 + hstep, voffB);
            PG8_WAIT_V(6); PG8_BAR; PG8_MMA(1, 1, At, B1); PG8_BAR;
            }
        }
        if constexpr (ALIGN_EPI) { if (wr == 0) PG8_BAR; }
        if constexpr (!Epi::AFTER_DRAIN) { E(acc, cur, wr, wc, fr, fq); S.done(cur); }
        if (!has_next) break;
#pragma unroll
        for (int a = 0; a < 2; ++a)
#pragma unroll
            for (int b = 0; b < 2; ++b)
#pragma unroll
                for (int m = 0; m < 4; ++m)
#pragma unroll
                    for (int n = 0; n < 2; ++n) acc[a][b][m][n] = (f32x4){0.f, 0.f, 0.f, 0.f};
        cur = nxt; cA = nA; cB = nB; ++ui;
        if constexpr (GATHER) {
#pragma unroll
            for (int h = 0; h < 2; ++h)
#pragma unroll
                for (int i = 0; i < 2; ++i) gAc[h][i] = gAn[h][i]; }
        if constexpr (ALIGN_EPI) { if (wr == 1) PG8_BAR; }
    }
    PG8_WAIT_V(0);
    if constexpr (!ALIGN_EPI) { if (wr == 0) PG8_BAR; }
    PG8_BAR;
    if constexpr (Epi::AFTER_DRAIN) { E.fused(acc, cur, wr, wc, fr, fq, lds, wid, lane); S.done(cur); }
#undef PG8_SA
#undef PG8_SB
#undef PG8_STAGE
#undef PG8_STAGE_B
#undef PG8_STAGE_A
#undef PG8_LDA
#undef PG8_LDB
#undef PG8_MMA
#undef PG8_WAIT_V
#undef PG8_WAIT_L
#undef PG8_BAR
#undef PG8_SCHED
}
}
#define XB_TMO      128
#define XB_XCNT(j)  (256  + 64 * (j))
#define XB_XSUB(j)  (1280 + 64 * (j))
#define XB_XGEN(j)  (2304 + 64 * (j))
#define XB_TOP      3328
#define XB_TOPGEN   3392
#define XCD_BAR_WORDS 3456
#define XB_SPIN_CAP (1u << 18)
#define LAS __attribute__((address_space(3)))

__device__ __forceinline__ unsigned xb_ld(unsigned* p)              { return __hip_atomic_load(p, __ATOMIC_RELAXED, __HIP_MEMORY_SCOPE_AGENT); }
__device__ __forceinline__ unsigned xb_add(unsigned* p, unsigned v) { return __hip_atomic_fetch_add(p, v, __ATOMIC_RELAXED, __HIP_MEMORY_SCOPE_AGENT); }
__device__ __forceinline__ unsigned xb_xcc_id() { return (unsigned)__builtin_amdgcn_s_getreg((3 << 11) | 20) & 0xFu; }
#define XB_SPIN(cond, bar) do { unsigned _sp = 0; while (cond) { __builtin_amdgcn_s_sleep(1); \
    if ((++_sp & 255u) == 0u) { if (xb_ld(&(bar)[XB_TMO])) break; if (_sp > XB_SPIN_CAP) { atomicAdd(&(bar)[XB_TMO], 1u); break; } } } } while (0)

struct XcdBarrier {
    unsigned* bar; unsigned x;
    volatile LAS unsigned* st;
};

__device__ __forceinline__ XcdBarrier xcd_barrier_post(unsigned* bar, volatile LAS unsigned* st) {
    XcdBarrier b; b.bar = bar; b.x = xb_xcc_id(); b.st = st;
    if (threadIdx.x == 0) (void)xb_add(&bar[XB_XCNT(b.x)], 1u);
    return b;
}
__device__ __forceinline__ void xcd_barrier_complete(unsigned* bar, unsigned x, unsigned& nloc, unsigned& nx) {
    const unsigned G = gridDim.x * gridDim.y * gridDim.z;
    unsigned sum, cnt, mine, sp = 0u;
    for (;;) {
        sum = 0u; cnt = 0u; mine = 0u;
#pragma unroll
        for (unsigned j = 0; j < 16; ++j) { const unsigned c = xb_ld(&bar[XB_XCNT(j)]); sum += c; cnt += (c > 0u) ? 1u : 0u; mine = (j == x) ? c : mine; }
        if (sum == G) break;
        __builtin_amdgcn_s_sleep(1);
        if ((++sp & 255u) == 0u) { if (xb_ld(&bar[XB_TMO])) break; if (sp > XB_SPIN_CAP) { atomicAdd(&bar[XB_TMO], 1u); break; } }
    }
    nloc = mine > 0u ? mine : 1u; nx = cnt > 0u ? cnt : 1u;
}

__device__ __forceinline__ void xcd_barrier(const XcdBarrier& b) {
    asm volatile("s_waitcnt vmcnt(0)" ::: "memory");
    __syncthreads();
    if (threadIdx.x == 0) {
        unsigned* bar = b.bar;
        __builtin_amdgcn_s_waitcnt(0);
        unsigned nloc = b.st[0], nx = b.st[1];
        if (nloc == 0u) { xcd_barrier_complete(bar, b.x, nloc, nx); b.st[0] = nloc; b.st[1] = nx; }
        const unsigned old = xb_add(&bar[XB_XSUB(b.x)], 1u);
        const unsigned gen = old / nloc;
        if (old + 1u == (gen + 1u) * nloc) {
            __builtin_amdgcn_fence(__ATOMIC_RELEASE, "agent");
            asm volatile("s_waitcnt vmcnt(0)" ::: "memory");
            const unsigned og = xb_add(&bar[XB_TOP], 1u);
            const unsigned tg = og / nx;
            if (og + 1u == (tg + 1u) * nx) xb_add(&bar[XB_TOPGEN], 1u);
            else XB_SPIN(xb_ld(&bar[XB_TOPGEN]) == tg, bar);
            __builtin_amdgcn_fence(__ATOMIC_ACQUIRE, "agent");
            xb_add(&bar[XB_XGEN(b.x)], 1u);
            asm volatile("s_waitcnt vmcnt(0)" ::: "memory");
        } else {
            XB_SPIN(xb_ld(&bar[XB_XGEN(b.x)]) == gen, bar);
            __builtin_amdgcn_fence(__ATOMIC_ACQUIRE, "agent");
            asm volatile("s_waitcnt vmcnt(0)" ::: "memory");
        }
    }
    __syncthreads();
}

#ifndef DIS
#define DIS 0
#endif
#ifndef SIDE_MASK
#define SIDE_MASK 15
#endif
#ifndef USE_GATHER_PHASE
#define USE_GATHER_PHASE 0
#endif
#ifndef CVT_NA
#define CVT_NA 325
#define CVT_NB 256
#define CVT_NC 47
#define CVT_ND 50
#endif
#ifndef CVT_TKQ
#define CVT_TKQ 64
#endif
#ifndef PRO_SPLIT
#define PRO_SPLIT 0
#endif
#ifndef CVT_MQ0
#define CVT_MQ0 160
#define CVT_MQ1 160
#endif
#ifndef MP_IN_MIXER
#define MP_IN_MIXER 0
#endif
#ifndef MO_IN_MIXER
#define MO_IN_MIXER 1
#endif
#ifndef PROBE_NACT
#define PROBE_NACT -1
#endif
#ifndef ATT_PRIO
#define ATT_PRIO 0
#endif
#ifndef ATT_G2
#define ATT_G2 0
#endif
#ifndef ATT_PD
#define ATT_PD 2
#endif
#ifndef GQA_SPLIT
#define GQA_SPLIT 0
#endif
#ifndef CVT_PRO8
#define CVT_PRO8 1
#endif
#ifndef CVT_SIDE8
#define CVT_SIDE8 1
#endif
#ifndef RPROBE1
#define RPROBE1 0
#define RPROBE2 0
#endif
#ifndef ROUTER_MFMA
#define ROUTER_MFMA 0
#endif
#ifndef ATTN_BODY
#define ATTN_BODY attn_body_sp
#endif
#ifndef MOE_ORDER_ALT
#define MOE_ORDER_ALT 1
#endif
#ifndef RPROBE_SKIP
#define RPROBE_SKIP 0
#endif
#ifndef CVT_NT_LOADS
#define CVT_NT_LOADS 1
#endif
#ifndef MOE_BAUX
#define MOE_BAUX 0
#endif
#ifndef REP
#define REP 0
#endif
typedef unsigned short bf16_t;
typedef short bf16x8 __attribute__((ext_vector_type(8)));
typedef short s16x4 __attribute__((ext_vector_type(4)));
typedef float f32x4 __attribute__((ext_vector_type(4)));
typedef float f32x16 __attribute__((ext_vector_type(16)));
typedef unsigned u32x4 __attribute__((ext_vector_type(4)));
typedef unsigned u32x2 __attribute__((ext_vector_type(2)));
using pg8::cvt_pk_bf16;

constexpr int DM = 2048, NB = 8, TPB = 2304  , NTOK = NB * TPB, NLAYER = 2;
constexpr int NPW = 4608;
constexpr int NEXP = 16;
constexpr float EPSN = 1e-6f;
constexpr float QSCALE_G = 0.08838834764831845f * 1.4426950408889634f;
constexpr float QSCALE_M = 0.07216878364870323f * 1.4426950408889634f;
constexpr int LDS_BYTES = 155648;
constexpr int LDS_MISC = LDS_BYTES - 64;

constexpr size_t al256(size_t x) { return (x + 255) / 256 * 256; }
constexpr size_t WS_CTL = 0;
constexpr size_t CTL_BYTES = 65536;
constexpr size_t CTL_Q = 16384;
constexpr size_t WS_MOD = WS_CTL + CTL_BYTES;
constexpr size_t WS_ROPEG = WS_MOD + al256((size_t)2 * 9 * 12288 * 4);
constexpr size_t WS_ROPEM = WS_ROPEG + (size_t)2048 * 64 * 2 * 4;
constexpr size_t WS_GI = WS_ROPEM + (size_t)2048 * 32 * 2 * 4;
constexpr size_t WS_GF = WS_GI + (size_t)2 * 8 * 4 * 2304 * 4;
constexpr size_t WS_AFF = WS_GF + (size_t)2 * 8 * 4 * 2304 * 4;
constexpr size_t WS_PTOK = WS_AFF + (size_t)8 * 16 * 2304 * 4;
constexpr size_t WS_PGV = WS_PTOK + (size_t)36864 * 4;
constexpr size_t WS_TOKSLOT = WS_PGV + (size_t)36864 * 4;
constexpr size_t WS_WIN = al256(WS_TOKSLOT + (size_t)NTOK * 16 * 4);
constexpr size_t WS_WOUT = WS_WIN + (size_t)2 * NPW * 2048 * 2;
constexpr size_t WS_WUQ = WS_WOUT + (size_t)2 * 2048 * 2048 * 2;
constexpr size_t WS_WUKV = WS_WUQ + (size_t)2 * 768 * 512 * 2;
constexpr size_t WS_WGU = WS_WUKV + (size_t)2 * 1024 * 256 * 2;
constexpr size_t WS_WD = WS_WGU + (size_t)2 * 16 * 4096 * 2048 * 2;
constexpr size_t WS_X = WS_WD + (size_t)2 * 16 * 2048 * 2048 * 2;
constexpr size_t WS_H = WS_X + (size_t)NTOK * 2048 * 4;
constexpr size_t WS_P = WS_H + (size_t)NTOK * 2048 * 2;
constexpr size_t WS_PG = WS_P + (size_t)NTOK * NPW * 2;
constexpr size_t WS_QG = WS_PG + (size_t)NTOK * 128 * 4;
constexpr size_t WS_KG = WS_QG + (size_t)NTOK * 1024 * 2;
constexpr size_t WS_QA = WS_KG + (size_t)NTOK * 256 * 2;
constexpr size_t WS_KVA = WS_QA + (size_t)NTOK * 512 * 2;
constexpr size_t WS_MQ = WS_KVA + (size_t)NTOK * 256 * 2;
constexpr size_t WS_MKV = WS_MQ + (size_t)NTOK * 768 * 2;
constexpr size_t WS_QM = WS_MKV + (size_t)NTOK * 1024 * 2;
constexpr size_t WS_KM = WS_QM + (size_t)NTOK * 768 * 2;
constexpr size_t WS_HF = WS_KM + (size_t)NTOK * 768 * 2;
constexpr size_t WS_HB = WS_HF + (size_t)NTOK * 512 * 4;
constexpr size_t WS_MIX = WS_HB + (size_t)NTOK * 512 * 4;
constexpr size_t WS_END = WS_MIX + (size_t)NTOK * 2048 * 2;
constexpr size_t WS_XG = WS_P, WS_ACT = WS_QG, WS_Y = WS_HF;
static_assert(WS_END <= (size_t)2147483648ull, "workspace map exceeds 2 GiB");
static_assert((size_t)36864 * 2048 * 2 <= (size_t)NTOK * NPW * 2, "XG overlay");
static_assert(WS_ACT + (size_t)36864 * 2048 * 2 <= WS_HF, "ACT overlay");
static_assert(WS_Y + (size_t)36864 * 2048 * 2 <= WS_END, "Y overlay");

struct Params {
    const float *x, *c, *ctx, *c_ctx, *ada_w, *ada_b, *norm1, *norm2, *w_in, *b_gates, *ml_norm, *gqa_q_norm, *gqa_k_norm, *mla_qa_norm, *mla_kva_norm,
                *mla_w_uq, *mla_w_ukv, *mla_q_norm, *mla_k_norm, *w_out, *w_router, *w_gate, *w_up, *w_down;
    float* out; unsigned char* ws; int ph_lo, ph_hi;
};

__device__ __forceinline__ float bflo(unsigned w) { return __uint_as_float(w << 16); }
__device__ __forceinline__ float bfhi(unsigned w) { return __uint_as_float(w & 0xffff0000u); }
__device__ __forceinline__ float wsum64(float v) { v += __shfl_xor(v, 32); v += __shfl_xor(v, 16); v += __shfl_xor(v, 8); v += __shfl_xor(v, 4); v += __shfl_xor(v, 2); v += __shfl_xor(v, 1); return v; }
__device__ __forceinline__ float gsum16(float v) { v += __shfl_xor(v, 8); v += __shfl_xor(v, 4); v += __shfl_xor(v, 2); v += __shfl_xor(v, 1); return v; }
__device__ __forceinline__ void unpack8(const u32x4 w, float (&f)[8]) { f[0] = bflo(w.x); f[1] = bfhi(w.x); f[2] = bflo(w.y); f[3] = bfhi(w.y); f[4] = bflo(w.z); f[5] = bfhi(w.z); f[6] = bflo(w.w); f[7] = bfhi(w.w); }
__device__ __forceinline__ u32x4 pack8(const float (&f)[8]) { u32x4 w; w.x = cvt_pk_bf16(f[0], f[1]); w.y = cvt_pk_bf16(f[2], f[3]); w.z = cvt_pk_bf16(f[4], f[5]); w.w = cvt_pk_bf16(f[6], f[7]); return w; }
template <int OFF> __device__ __forceinline__ s16x4 tr_read(unsigned addr) {
    s16x4 r; asm volatile("ds_read_b64_tr_b16 %0, %1 offset:%2" : "=&v"(r) : "v"(addr), "i"(OFF) : "memory"); return r;
}
#define LGKM0() do { asm volatile("s_waitcnt lgkmcnt(0)" ::: "memory"); __builtin_amdgcn_sched_barrier(0); } while (0)
#define PK8(L, H) (bf16x8){L[0], L[1], L[2], L[3], H[0], H[1], H[2], H[3]}
namespace att {
constexpr int NW = 8, QBLK = 32, KVBLK = 64;
constexpr float THR_L2 = 11.5f;
template <int DQK> struct Cfg {
    static constexpr int KP = DQK / 8;
    static constexpr int NKP = 64 * KP / 512;
    static constexpr int QSP = 0;
    static constexpr int KPITCH = DQK == 128 ? 256 : 512;
    static constexpr int SHM_V = KVBLK * 128 * 2, SHM_K = KVBLK * KPITCH, OFF_QSP = 2 * SHM_V + 2 * SHM_K + NW * 64 * 4, SHM = OFF_QSP + NW * QSP * 1024;
};
#define SBAR() __builtin_amdgcn_sched_barrier(0)
__device__ __forceinline__ int crow(int r, int hi) { return (r & 3) + 8 * (r >> 2) + 4 * hi; }
__device__ __forceinline__ void partialSM(f32x16& p0, f32x16& p1, float& m_reg, float& mn, float& alpha) {
    float pmax = p0[0];
#pragma unroll
    for (int r = 1; r < 16; ++r) pmax = fmaxf(pmax, p0[r]);
#pragma unroll
    for (int r = 0; r < 16; ++r) pmax = fmaxf(pmax, p1[r]);
    { auto rr = __builtin_amdgcn_permlane32_swap(__float_as_uint(pmax), __float_as_uint(pmax), false, false);
      pmax = fmaxf(__uint_as_float(rr[0]), __uint_as_float(rr[1])); }
    if (__builtin_expect(__all(pmax - m_reg <= THR_L2), 1)) { mn = m_reg; alpha = 1.f; }
    else { mn = fmaxf(m_reg, pmax); alpha = __builtin_amdgcn_exp2f(m_reg - mn); m_reg = mn; }
#pragma unroll
    for (int r = 0; r < 16; ++r) p0[r] = p0[r] - mn;
#pragma unroll
    for (int r = 0; r < 16; ++r) p1[r] = p1[r] - mn;
#pragma unroll
    for (int r = 0; r < 16; ++r) p0[r] = __builtin_amdgcn_exp2f(p0[r]);
}
__device__ __forceinline__ void finishSM(f32x16& p0, f32x16& p1, float alpha, float& l_reg, bf16x8& pa0, bf16x8& pa1, bf16x8& pa2, bf16x8& pa3) {
#pragma unroll
    for (int r = 0; r < 16; ++r) p1[r] = __builtin_amdgcn_exp2f(p1[r]);
    float ps = 0;
#pragma unroll
    for (int r = 0; r < 16; ++r) ps += p0[r];
#pragma unroll
    for (int r = 0; r < 16; ++r) ps += p1[r];
    { auto rr = __builtin_amdgcn_permlane32_swap(__float_as_uint(ps), __float_as_uint(ps), false, false);
      ps = __uint_as_float(rr[0]) + __uint_as_float(rr[1]); }
    l_reg = l_reg * alpha + ps;
#define PK4(P, BASE, OUT) do { unsigned a0 = cvt_pk_bf16(P[BASE + 0], P[BASE + 1]), a1 = cvt_pk_bf16(P[BASE + 2], P[BASE + 3]);   \
    unsigned b0 = cvt_pk_bf16(P[BASE + 4], P[BASE + 5]), b1 = cvt_pk_bf16(P[BASE + 6], P[BASE + 7]);                              \
    auto r0 = __builtin_amdgcn_permlane32_swap(a0, b0, false, false); auto r1 = __builtin_amdgcn_permlane32_swap(a1, b1, false, false); \
    u32x4 w = {r0[0], r1[0], r0[1], r1[1]}; OUT = *reinterpret_cast<bf16x8*>(&w); } while (0)
    PK4(p0, 0, pa0); PK4(p0, 8, pa1); PK4(p1, 0, pa2); PK4(p1, 8, pa3);
#undef PK4
}
template <int DQK> __device__ __forceinline__ int kswz(int row, int colB) { return row * Cfg<DQK>::KPITCH + (colB ^ ((row & 15) << 4)); }
template <int DQK> __device__ __forceinline__ void qkt(f32x16& p0, f32x16& p1, const LAS unsigned char* Ks, const bf16x8* qr, const LAS unsigned char* qsp, int r32, int hi) {
    constexpr int NR = DQK / 16 - Cfg<DQK>::QSP;
    p0 = f32x16{}; p1 = f32x16{};
#pragma unroll
    for (int d0 = 0; d0 < DQK / 16; ++d0) { const int cb = (d0 * 16 + hi * 8) * 2;
        const bf16x8 b0 = *(const LAS bf16x8*)(Ks + kswz<DQK>(r32, cb));
        const bf16x8 b1 = *(const LAS bf16x8*)(Ks + kswz<DQK>(32 + r32, cb));
        bf16x8 qf;
        if (d0 < NR) qf = qr[d0 < NR ? d0 : 0]; else qf = *(const LAS bf16x8*)(qsp + (d0 - NR) * 1024);
        p0 = __builtin_amdgcn_mfma_f32_32x32x16_bf16(b0, qf, p0, 0, 0, 0);
        p1 = __builtin_amdgcn_mfma_f32_32x32x16_bf16(b1, qf, p1, 0, 0, 0);
        if (DQK > 128 && (d0 & 3) == 3 && d0 + 1 < DQK / 16) SBAR(); }
}
__device__ __forceinline__ int v_st(int k, int c) { const int kk = (k & ~0xC) | ((k & 4) << 1) | ((k & 8) >> 1); return ((kk >> 3) * 4 + (c >> 5)) * 512 + ((kk & 7) * 32 + (c & 31)) * 2; }
__device__ __forceinline__ int v_rd_base(int lane) { return ((lane & 3) << 3) | (((lane >> 2) & 3) << 6) | (((lane >> 4) & 1) << 5) | (((lane >> 5) & 1) << 8); }
constexpr int v_rd_off(int d0, int ks, int half) { return d0 * 512 + ks * 4096 + half * 2048; }
template <int D0> __device__ __forceinline__ void pv_one(f32x16& od, unsigned vb, bf16x8 pa0, bf16x8 pa1, bf16x8 pa2, bf16x8 pa3) {
    const s16x4 l0 = tr_read<v_rd_off(D0, 0, 0)>(vb), h0 = tr_read<v_rd_off(D0, 0, 1)>(vb), l1 = tr_read<v_rd_off(D0, 1, 0)>(vb), h1 = tr_read<v_rd_off(D0, 1, 1)>(vb);
    const s16x4 l2 = tr_read<v_rd_off(D0, 2, 0)>(vb), h2 = tr_read<v_rd_off(D0, 2, 1)>(vb), l3 = tr_read<v_rd_off(D0, 3, 0)>(vb), h3 = tr_read<v_rd_off(D0, 3, 1)>(vb);
    asm volatile("s_waitcnt lgkmcnt(0)" ::: "memory"); SBAR();
    od = __builtin_amdgcn_mfma_f32_32x32x16_bf16(pa0, PK8(l0, h0), od, 0, 0, 0);
    od = __builtin_amdgcn_mfma_f32_32x32x16_bf16(pa1, PK8(l1, h1), od, 0, 0, 0);
    od = __builtin_amdgcn_mfma_f32_32x32x16_bf16(pa2, PK8(l2, h2), od, 0, 0, 0);
    od = __builtin_amdgcn_mfma_f32_32x32x16_bf16(pa3, PK8(l3, h3), od, 0, 0, 0);
}
__device__ __forceinline__ void pv_d0(f32x16* o, unsigned vb, bf16x8 pa0, bf16x8 pa1, bf16x8 pa2, bf16x8 pa3) {
    pv_one<0>(o[0], vb, pa0, pa1, pa2, pa3); pv_one<1>(o[1], vb, pa0, pa1, pa2, pa3); pv_one<2>(o[2], vb, pa0, pa1, pa2, pa3); pv_one<3>(o[3], vb, pa0, pa1, pa2, pa3);
}

template <int DQK, int SDEPTH, int ldq, int ldk, int ldv, int ldo>
__device__ __forceinline__ void attn_body(const bf16_t* __restrict__ Qb, const bf16_t* __restrict__ Kh, const bf16_t* __restrict__ Vh,
                                          bf16_t* __restrict__ Ob, int seq, LAS unsigned char* lds) {
    using C = Cfg<DQK>;
    constexpr int SHM_V = C::SHM_V, SHM_K = C::SHM_K, NKP = C::NKP, KP = C::KP;
    int tid_ = threadIdx.x; asm volatile("" : "+v"(tid_));
    const int tid = tid_, wid = tid >> 6, lane = tid & 63, r32 = lane & 31, hi = lane >> 5;
    LAS unsigned char* V_lds = lds; LAS unsigned char* K_lds = lds + 2 * SHM_V;
    LAS float* ws = (LAS float*)(lds + 2 * SHM_V + 2 * SHM_K) + wid * 64; LAS float* li_l = ws; LAS float* al_l = ws + 32;
    constexpr int NR = DQK / 16 - C::QSP;
    float m_reg = -1e30f, l_reg = 0; f32x16 o[4] = {}; bf16x8 qr[NR];
    const bf16_t* Qw = Qb + (long)(wid * QBLK + r32) * ldq + hi * 8;
#pragma unroll
    for (int d0 = 0; d0 < NR; ++d0) qr[d0] = *(const bf16x8*)(Qw + d0 * 16);
    LAS unsigned char* qsp = lds + C::OFF_QSP + wid * (C::QSP * 1024) + lane * 16;
#pragma unroll
    for (int d0 = NR; d0 < DQK / 16; ++d0) *(LAS bf16x8*)(qsp + (d0 - NR) * 1024) = *(const bf16x8*)(Qw + d0 * 16);
    const int sr = tid >> 4, sc = (tid & 15) * 8, vst0 = v_st(sr, sc), vst1 = v_st(32 + sr, sc);
    const int krow = tid >> 3, kc16 = tid & 7;
    const int kst = krow * (DQK * 2) + ((kc16 * 16) ^ ((krow & 7) << 4));
    const unsigned vb0 = (unsigned)(uintptr_t)V_lds + (unsigned)v_rd_base(lane);
    struct { bf16x8 vs0, vs1, ks[NKP]; } sr_[SDEPTH];
    const __amdgpu_buffer_rsrc_t rsK = __builtin_amdgcn_make_buffer_rsrc((void*)Kh, (short)0, 0x7ffffff0, 0x00020000);
    const __amdgpu_buffer_rsrc_t rsV = __builtin_amdgcn_make_buffer_rsrc((void*)Vh, (short)0, 0x7ffffff0, 0x00020000);
    const int voffK = (krow * ldk + kc16 * 8) * 2, voffV = (sr * ldv + sc) * 2;
#define SLOAD(i, k0) do { { const u32x4 _t = __builtin_amdgcn_raw_buffer_load_b128(rsV, voffV, (k0) * (ldv * 2), 0); sr_[i].vs0 = *(const bf16x8*)&_t; } \
    { const u32x4 _t = __builtin_amdgcn_raw_buffer_load_b128(rsV, voffV, ((k0) + 32) * (ldv * 2), 0); sr_[i].vs1 = *(const bf16x8*)&_t; } \
    _Pragma("unroll") for (int _q = 0; _q < NKP; ++_q) { const u32x4 _t = __builtin_amdgcn_raw_buffer_load_b128(rsK, voffK, (k0) * (ldk * 2) + _q * 128, 0); sr_[i].ks[_q] = *(const bf16x8*)&_t; } } while (0)
#define SWRITE(b, i) do { *(LAS bf16x8*)(V_lds + (b) * SHM_V + vst0) = sr_[i].vs0; *(LAS bf16x8*)(V_lds + (b) * SHM_V + vst1) = sr_[i].vs1; \
    _Pragma("unroll") for (int _q = 0; _q < NKP; ++_q) *(LAS bf16x8*)(K_lds + (b) * SHM_K + kst + _q * 128) = sr_[i].ks[_q]; } while (0)
#define SWAIT() do { if constexpr (SDEPTH == 2) asm volatile("s_waitcnt vmcnt(%0)" :: "n"(2 + NKP) : "memory"); else asm volatile("s_waitcnt vmcnt(0)" ::: "memory"); } while (0)
#define RESC(a) do { if (__any((a) < 1.f)) { int _t2 = threadIdx.x; asm volatile("" : "+v"(_t2));   \
    LAS float* _al = (LAS float*)(lds + 2 * SHM_V + 2 * SHM_K) + (_t2 >> 6) * 64 + 32; const int _r2 = _t2 & 31, _h2 = (_t2 >> 5) & 1; \
    if (_h2 == 0) _al[_r2] = (a); asm volatile("s_waitcnt lgkmcnt(0)" ::: "memory"); \
    _Pragma("unroll") for (int d = 0; d < 4; ++d) _Pragma("unroll") for (int r = 0; r < 16; ++r) o[d][r] *= _al[crow(r, _h2)]; } } while (0)
    f32x16 pA0, pA1, pB0, pB1; float mnA, mnB, alA, alB; bf16x8 pa0, pa1, pa2, pa3; const int NT = seq / KVBLK;
    constexpr int SE = 0, SO = SDEPTH - 1;
    SLOAD(SE, 0); asm volatile("s_waitcnt vmcnt(0)" ::: "memory"); SWRITE(0, SE); __syncthreads();
    qkt<DQK>(pA0, pA1, K_lds, qr, qsp, r32, hi); partialSM(pA0, pA1, m_reg, mnA, alA);
    SLOAD(SO, KVBLK); if constexpr (SDEPTH == 2) { if (2 < NT) SLOAD(SE, 2 * KVBLK); }
    SWAIT(); SWRITE(1, SO); __syncthreads();
    for (int j = 1; j + 1 < NT; j += 2) {
        SBAR(); qkt<DQK>(pB0, pB1, K_lds + SHM_K, qr, qsp, r32, hi);
        finishSM(pA0, pA1, alA, l_reg, pa0, pa1, pa2, pa3); SBAR();
        SLOAD(SO, (j + SDEPTH) * KVBLK); SBAR();
        pv_d0(o, vb0, pa0, pa1, pa2, pa3); partialSM(pB0, pB1, m_reg, mnB, alB);
        __syncthreads(); SWAIT(); SWRITE(0, SE);
        RESC(alB); __syncthreads();
        SBAR(); qkt<DQK>(pA0, pA1, K_lds, qr, qsp, r32, hi);
        finishSM(pB0, pB1, alB, l_reg, pa0, pa1, pa2, pa3); SBAR();
        if (SDEPTH == 1 || j + 3 < NT) SLOAD(SE, (j + 1 + SDEPTH) * KVBLK); SBAR();
        pv_d0(o, vb0 + (unsigned)SHM_V, pa0, pa1, pa2, pa3); partialSM(pA0, pA1, m_reg, mnA, alA);
        __syncthreads(); SWAIT(); SWRITE(1, SO);
        RESC(alA); __syncthreads();
    }
    SBAR(); qkt<DQK>(pB0, pB1, K_lds + SHM_K, qr, qsp, r32, hi);
    finishSM(pA0, pA1, alA, l_reg, pa0, pa1, pa2, pa3); SBAR();
    pv_d0(o, vb0, pa0, pa1, pa2, pa3); partialSM(pB0, pB1, m_reg, mnB, alB);
    __syncthreads(); RESC(alB);
    finishSM(pB0, pB1, alB, l_reg, pa0, pa1, pa2, pa3); SBAR();
    pv_d0(o, vb0 + (unsigned)SHM_V, pa0, pa1, pa2, pa3);
    {
        int t3 = threadIdx.x; asm volatile("" : "+v"(t3));
        const int wid3 = t3 >> 6, r3 = t3 & 31, h3 = (t3 >> 5) & 1, odd = t3 & 1;
        LAS float* li3 = (LAS float*)(lds + 2 * SHM_V + 2 * SHM_K) + wid3 * 64;
        if (h3 == 0) li3[r3] = l_reg; asm volatile("s_waitcnt lgkmcnt(0)" ::: "memory");
        float rli[16];
#pragma unroll
        for (int r = 0; r < 16; ++r) rli[r] = __builtin_amdgcn_rcpf(li3[crow(r, h3)]);
        bf16_t* Ow = Ob + (long)(wid3 * QBLK) * ldo + (r3 & ~1);
#pragma unroll
        for (int r = 0; r < 16; r += 2) {
#pragma unroll
            for (int d0 = 0; d0 < 4; ++d0) {
                const float a = o[d0][r] * rli[r], bq = o[d0][r + 1] * rli[r + 1];
                const float xs = odd ? a : bq;
                const float y = __uint_as_float((unsigned)__builtin_amdgcn_update_dpp(0, (int)__float_as_uint(xs), 0xB1, 0xF, 0xF, true));
                const int orow = odd ? crow(r + 1, h3) : crow(r, h3);
                const unsigned w = odd ? cvt_pk_bf16(y, bq) : cvt_pk_bf16(a, y);
                *(unsigned*)(Ow + (long)orow * ldo + d0 * 32) = w;
            }
        }
    }
#undef SLOAD
#undef SWRITE
#undef SWAIT
#undef RESC
}

#define FX_CHUNK(P, G) do { const float _e0 = __builtin_amdgcn_exp2f(P[2 * (G)]), _e1 = __builtin_amdgcn_exp2f(P[2 * (G) + 1]); asm volatile("v_add_f32 %0, %0, %1" : "+v"(psa) : "v"(_e0)); asm volatile("v_add_f32 %0, %0, %1" : "+v"(psb) : "v"(_e1)); cv[G] = cvt_pk_bf16(_e0, _e1); } while (0)
#define FX_PACK(PA, B) do { auto _r0 = __builtin_amdgcn_permlane32_swap(cv[B], cv[(B) + 2], false, false); auto _r1 = __builtin_amdgcn_permlane32_swap(cv[(B) + 1], cv[(B) + 3], false, false); \
    u32x4 _w = {_r0[0], _r1[0], _r0[1], _r1[1]}; PA = *reinterpret_cast<bf16x8*>(&_w); } while (0)
#define FX_VRD(T) do { constexpr int _s = (T) % (PD + 1), _d = (T) & 3, _k = (T) >> 2; vl[_s] = tr_read<v_rd_off(_d, _k, 0)>(vb); vh[_s] = tr_read<v_rd_off(_d, _k, 1)>(vb); } while (0)
#define FX_PV(T) do { constexpr int _s = (T) % (PD + 1), _d = (T) & 3, _k = (T) >> 2, _nw = 2 * ((15 - (T)) < PD ? (15 - (T)) : PD); \
    asm volatile("s_waitcnt lgkmcnt(%2)" : "+v"(vl[_s]), "+v"(vh[_s]) : "n"(_nw) : "memory"); \
    o[_d] = __builtin_amdgcn_mfma_f32_32x32x16_bf16(pa[_k], PK8(vl[_s], vh[_s]), o[_d], 0, 0, 0); } while (0)
#define FX_GAP(T, EXTRA) do { if constexpr ((T) + PD < 16) { FX_VRD(((T) + PD) & 15); } FX_PV(T); EXTRA; SBAR(); } while (0)
template <int DQK, class ST>
__device__ __forceinline__ void tile_fx(f32x16 (&o)[4], float& l_reg, const LAS unsigned char* Kb, const unsigned vb, const bf16x8 (&qr)[DQK / 16], const int r32, const int hi, const ST& st) {
    constexpr int ND = DQK / 16, NS = 2 * ND, PD = ATT_PD;
    static_assert(PD >= 2 && PD <= 4, "prefetch distance");
    f32x16 p0 = f32x16{}, p1 = f32x16{};
    bf16x8 kf[PD + 1], pa[4]; s16x4 vl[PD + 1], vh[PD + 1]; unsigned cv[8]; float psa = 0.f, psb = 0.f;
#define FX_KRD(S) (*(const LAS bf16x8*)(Kb + kswz<DQK>(((S) < ND ? 0 : 32) + r32, (((S) < ND ? (S) : (S) - ND) * 16 + hi * 8) * 2)))
#pragma unroll
    for (int s = 0; s < PD; ++s) kf[s] = FX_KRD(s);
#pragma unroll
    for (int s = 0; s < NS; ++s) {
        if (s + PD < NS) kf[(s + PD) % (PD + 1)] = FX_KRD(s + PD);
        if (s < ND) p0 = __builtin_amdgcn_mfma_f32_32x32x16_bf16(kf[s % (PD + 1)], qr[s], p0, 0, 0, 0);
        else { const int g = s - ND;
            p1 = __builtin_amdgcn_mfma_f32_32x32x16_bf16(kf[s % (PD + 1)], qr[g], p1, 0, 0, 0);
            if (g < 8) FX_CHUNK(p0, g);
            if (g == 4) FX_PACK(pa[0], 0);
            if (g == (ND == 8 ? 7 : 8)) FX_PACK(pa[1], 4); }
        if (s == NS - 4 && PD >= 4) FX_VRD(PD - 4);
        if (s == NS - 3 && PD >= 3) FX_VRD(PD - 3);
        if (s == NS - 2) FX_VRD(PD - 2);
        if (s == NS - 1) FX_VRD(PD - 1);
        SBAR();
    }
#undef FX_KRD
    FX_GAP(0, FX_CHUNK(p1, 0)); FX_GAP(1, FX_CHUNK(p1, 1)); FX_GAP(2, FX_CHUNK(p1, 2)); FX_GAP(3, FX_CHUNK(p1, 3));
    FX_GAP(4, FX_CHUNK(p1, 4); FX_PACK(pa[2], 0)); FX_GAP(5, FX_CHUNK(p1, 5)); FX_GAP(6, FX_CHUNK(p1, 6)); FX_GAP(7, FX_CHUNK(p1, 7));
    FX_GAP(8, FX_PACK(pa[3], 4));
    FX_GAP(9, { float ps = psa + psb; auto rr = __builtin_amdgcn_permlane32_swap(__float_as_uint(ps), __float_as_uint(ps), false, false); l_reg += __uint_as_float(rr[0]) + __uint_as_float(rr[1]); });
    FX_GAP(10, st(0)); FX_GAP(11, st(1)); FX_GAP(12, st(2)); FX_GAP(13, st(3)); FX_GAP(14, st(4)); FX_GAP(15, st(5));
}
#undef FX_CHUNK
#undef FX_PACK
#undef FX_VRD
#undef FX_PV
#undef FX_GAP

template <int DQK, int ldq, int ldk, int ldv, int ldo>
__device__ __forceinline__ void attn_body_sp(const bf16_t* __restrict__ Qb, const bf16_t* __restrict__ Kh, const bf16_t* __restrict__ Vh,
                                             bf16_t* __restrict__ Ob, int seq, LAS unsigned char* lds, const bool usemax, const int nact = 8) {
    using C = Cfg<DQK>;
    constexpr int SHM_V = C::SHM_V, SHM_K = C::SHM_K, NKP = C::NKP, NR = DQK / 16 - C::QSP;
    int tid_ = threadIdx.x; asm volatile("" : "+v"(tid_));
    const int tid = tid_, wid = tid >> 6, lane = tid & 63, r32 = lane & 31, hi = lane >> 5;
    const bool act = __builtin_amdgcn_readfirstlane(wid) < nact;
    LAS unsigned char* V_lds = lds; LAS unsigned char* K_lds = lds + 2 * SHM_V;
    float m_reg = -1e30f, l_reg = 0; f32x16 o[4] = {}; bf16x8 qr[NR];
    const bf16_t* Qw = Qb + (long)(wid * QBLK + r32) * ldq + hi * 8;
    if (act) {
#pragma unroll
    for (int d0 = 0; d0 < NR; ++d0) qr[d0] = *(const bf16x8*)(Qw + d0 * 16);
    } else {
#pragma unroll
    for (int d0 = 0; d0 < NR; ++d0) qr[d0] = bf16x8{};
    }
    LAS unsigned char* qsp = lds + C::OFF_QSP + wid * (C::QSP * 1024) + lane * 16;
#pragma unroll
    for (int d0 = NR; d0 < DQK / 16; ++d0) *(LAS bf16x8*)(qsp + (d0 - NR) * 1024) = *(const bf16x8*)(Qw + d0 * 16);
    const int sr = tid >> 4, sc = (tid & 15) * 8, vst0 = v_st(sr, sc), vst1 = v_st(32 + sr, sc);
    const int krow = tid >> 3, kc16 = tid & 7;
    const int kstA = krow * C::KPITCH + ((kc16 * 16) ^ ((krow & 15) << 4)), kstB = krow * C::KPITCH + ((kc16 * 16 + 128) ^ ((krow & 15) << 4));
    const unsigned vb0 = (unsigned)(uintptr_t)V_lds + (unsigned)v_rd_base(lane);
    const __amdgpu_buffer_rsrc_t rsK = __builtin_amdgcn_make_buffer_rsrc((void*)Kh, (short)0, 0x7ffffff0, 0x00020000);
    const __amdgpu_buffer_rsrc_t rsV = __builtin_amdgcn_make_buffer_rsrc((void*)Vh, (short)0, 0x7ffffff0, 0x00020000);
    const int voffK = (krow * ldk + kc16 * 8) * 2, voffV = (sr * ldv + sc) * 2;
    u32x4 svs0, svs1, sks[NKP];
#define SLOAD1(k0) do { svs0 = __builtin_amdgcn_raw_buffer_load_b128(rsV, voffV, (k0) * (ldv * 2), 0); svs1 = __builtin_amdgcn_raw_buffer_load_b128(rsV, voffV, ((k0) + 32) * (ldv * 2), 0); \
    _Pragma("unroll") for (int _q = 0; _q < NKP; ++_q) sks[_q] = __builtin_amdgcn_raw_buffer_load_b128(rsK, voffK, (k0) * (ldk * 2) + _q * 128, 0); } while (0)
#define SWRITE1(b) do { *(LAS u32x4*)(V_lds + (b) * SHM_V + vst0) = svs0; *(LAS u32x4*)(V_lds + (b) * SHM_V + vst1) = svs1; \
    _Pragma("unroll") for (int _q = 0; _q < NKP; ++_q) *(LAS u32x4*)(K_lds + (b) * SHM_K + (_q == 1 ? kstB : kstA + (_q >> 1) * 256)) = sks[_q]; } while (0)
    const int NT = seq / KVBLK;
    SLOAD1(0); SWRITE1(0); SLOAD1(KVBLK); __syncthreads();
    if (ATT_PRIO && __builtin_amdgcn_readfirstlane(wid) >= 4) __builtin_amdgcn_s_setprio(1);
    if (usemax) {
#pragma unroll 2
    for (int j = 0; j < NT; ++j) {
        const int bsel = j & 1;
        if (act) {
        f32x16 p0, p1; float mn, al; bf16x8 pa0, pa1, pa2, pa3;
        qkt<DQK>(p0, p1, K_lds + bsel * SHM_K, qr, qsp, r32, hi);
        partialSM(p0, p1, m_reg, mn, al);
        if (__any(al < 1.f)) { int _t2 = threadIdx.x; asm volatile("" : "+v"(_t2));
            LAS float* _al = (LAS float*)(lds + 2 * SHM_V + 2 * SHM_K) + (_t2 >> 6) * 64 + 32; const int _r2 = _t2 & 31, _h2 = (_t2 >> 5) & 1;
            if (_h2 == 0) _al[_r2] = al; asm volatile("s_waitcnt lgkmcnt(0)" ::: "memory");
#pragma unroll
            for (int d = 0; d < 4; ++d)
#pragma unroll
                for (int r = 0; r < 16; ++r) o[d][r] *= _al[crow(r, _h2)]; }
        finishSM(p0, p1, al, l_reg, pa0, pa1, pa2, pa3); SBAR();
        pv_d0(o, vb0 + (unsigned)(bsel * SHM_V), pa0, pa1, pa2, pa3);
        }
        if (j + 1 < NT) { SWRITE1(bsel ^ 1); if (j + 2 < NT) SLOAD1((j + 2) * KVBLK); }
        __syncthreads();
    }
    } else if constexpr (DQK != 128 || !ATT_G2) {
#pragma unroll 2
    for (int j = 0; j < NT; ++j) {
        const int bsel = j & 1; const bool dw = j + 1 < NT, dl = j + 2 < NT;
        auto st = [&](int i) {
            if (dw) {
                if (i == 0) *(LAS u32x4*)(V_lds + (bsel ^ 1) * SHM_V + vst0) = svs0;
                if (i == 1) *(LAS u32x4*)(V_lds + (bsel ^ 1) * SHM_V + vst1) = svs1;
                if (i == 2) *(LAS u32x4*)(K_lds + (bsel ^ 1) * SHM_K + kstA) = sks[0];
                if (i == 3) *(LAS u32x4*)(K_lds + (bsel ^ 1) * SHM_K + kstB) = sks[1];
                if (i == 4 && NKP == 3) *(LAS u32x4*)(K_lds + (bsel ^ 1) * SHM_K + kstA + 256) = sks[NKP - 1];
            }
            if (i == 5 && dl) SLOAD1((j + 2) * KVBLK);
        };
        if (act) tile_fx<DQK>(o, l_reg, K_lds + bsel * SHM_K, vb0 + (unsigned)(bsel * SHM_V), qr, r32, hi, st);
        else { st(0); st(1); st(2); st(3); st(4); st(5); }
        __syncthreads();
    }
    } else {
    u32x4 svt0, svt1, skt[NKP];
#define SLOAD2(k0) do { svt0 = __builtin_amdgcn_raw_buffer_load_b128(rsV, voffV, (k0) * (ldv * 2), 0); svt1 = __builtin_amdgcn_raw_buffer_load_b128(rsV, voffV, ((k0) + 32) * (ldv * 2), 0); \
    _Pragma("unroll") for (int _q = 0; _q < NKP; ++_q) skt[_q] = __builtin_amdgcn_raw_buffer_load_b128(rsK, voffK, (k0) * (ldk * 2) + _q * 128, 0); } while (0)
#define SWRITE2(b) do { *(LAS u32x4*)(V_lds + (b) * SHM_V + vst0) = svt0; *(LAS u32x4*)(V_lds + (b) * SHM_V + vst1) = svt1; \
    _Pragma("unroll") for (int _q = 0; _q < NKP; ++_q) *(LAS u32x4*)(K_lds + (b) * SHM_K + (_q == 1 ? kstB : kstA + (_q >> 1) * 256)) = skt[_q]; } while (0)
    if (2 < NT) SLOAD2(2 * KVBLK);
    for (int j = 0; j < NT; j += 2) {
        if (act) tile_fx<DQK>(o, l_reg, K_lds, vb0, qr, r32, hi, [](int) {});
        SWRITE1(1); if (j + 3 < NT) SLOAD1((j + 3) * KVBLK);
        __syncthreads();
        if (act) tile_fx<DQK>(o, l_reg, K_lds + SHM_K, vb0 + (unsigned)SHM_V, qr, r32, hi, [](int) {});
        if (j + 2 < NT) { SWRITE2(0); if (j + 4 < NT) SLOAD2((j + 4) * KVBLK); }
        __syncthreads();
    }
#undef SLOAD2
#undef SWRITE2
    }
#undef SLOAD1
#undef SWRITE1
    if (ATT_PRIO) __builtin_amdgcn_s_setprio(0);
    if (act) {
        int t3 = threadIdx.x; asm volatile("" : "+v"(t3));
        const int wid3 = t3 >> 6, r3 = t3 & 31, h3 = (t3 >> 5) & 1, odd = t3 & 1;
        LAS float* li3 = (LAS float*)(lds + 2 * SHM_V + 2 * SHM_K) + wid3 * 64;
        if (h3 == 0) li3[r3] = l_reg; asm volatile("s_waitcnt lgkmcnt(0)" ::: "memory");
        float rli[16];
#pragma unroll
        for (int r = 0; r < 16; ++r) rli[r] = __builtin_amdgcn_rcpf(li3[crow(r, h3)]);
        bf16_t* Ow = Ob + (long)(wid3 * QBLK) * ldo + (r3 & ~1);
#pragma unroll
        for (int r = 0; r < 16; r += 2) {
#pragma unroll
            for (int d0 = 0; d0 < 4; ++d0) {
                const float a = o[d0][r] * rli[r], bq = o[d0][r + 1] * rli[r + 1];
                const float xs = odd ? a : bq;
                const float y = __uint_as_float((unsigned)__builtin_amdgcn_update_dpp(0, (int)__float_as_uint(xs), 0xB1, 0xF, 0xF, true));
                const int orow = odd ? crow(r + 1, h3) : crow(r, h3);
                const unsigned w = odd ? cvt_pk_bf16(y, bq) : cvt_pk_bf16(a, y);
                *(unsigned*)(Ow + (long)orow * ldo + d0 * 32) = w;
            }
        }
    }
}
template <int DQK, int ldq, int ldk, int ldv, int ldo>
__device__ __forceinline__ void attn_body_st(const bf16_t* __restrict__ Qb, const bf16_t* __restrict__ Kh, const bf16_t* __restrict__ Vh,
                                             bf16_t* __restrict__ Ob, int seq, LAS unsigned char* lds) {
    using C = Cfg<DQK>;
    constexpr int SHM_V = C::SHM_V, SHM_K = C::SHM_K, NKP = C::NKP, NR = DQK / 16, OFF_K = 3 * SHM_V, OFF_WS = 3 * SHM_V + 2 * SHM_K;
    int tid_ = threadIdx.x; asm volatile("" : "+v"(tid_));
    const int tid = tid_, wid = tid >> 6, lane = tid & 63, r32 = lane & 31, hi = lane >> 5;
    const bool lag = __builtin_amdgcn_readfirstlane(wid) >= 4;
    LAS unsigned char* V_lds = lds; LAS unsigned char* K_lds = lds + OFF_K;
    float m_reg = -1e30f, l_reg = 0; f32x16 o[4] = {}; bf16x8 qr[NR];
    const bf16_t* Qw = Qb + (long)(wid * QBLK + r32) * ldq + hi * 8;
#pragma unroll
    for (int d0 = 0; d0 < NR; ++d0) qr[d0] = *(const bf16x8*)(Qw + d0 * 16);
    const int sr = tid >> 4, sc = (tid & 15) * 8, vst0 = v_st(sr, sc), vst1 = v_st(32 + sr, sc);
    const int krow = tid >> 3, kc16 = tid & 7;
    const int kst = krow * (DQK * 2) + ((kc16 * 16) ^ ((krow & 7) << 4));
    const unsigned vb0 = (unsigned)(uintptr_t)V_lds + (unsigned)v_rd_base(lane);
    const __amdgpu_buffer_rsrc_t rsK = __builtin_amdgcn_make_buffer_rsrc((void*)Kh, (short)0, 0x7ffffff0, 0x00020000);
    const __amdgpu_buffer_rsrc_t rsV = __builtin_amdgcn_make_buffer_rsrc((void*)Vh, (short)0, 0x7ffffff0, 0x00020000);
    const int voffK = (krow * ldk + kc16 * 8) * 2, voffV = (sr * ldv + sc) * 2;
    u32x4 svs0, svs1, sks[NKP];
#define SLOAD1(k0) do { svs0 = __builtin_amdgcn_raw_buffer_load_b128(rsV, voffV, (k0) * (ldv * 2), 0); svs1 = __builtin_amdgcn_raw_buffer_load_b128(rsV, voffV, ((k0) + 32) * (ldv * 2), 0); \
    _Pragma("unroll") for (int _q = 0; _q < NKP; ++_q) sks[_q] = __builtin_amdgcn_raw_buffer_load_b128(rsK, voffK, (k0) * (ldk * 2) + _q * 128, 0); } while (0)
#define SWRITE2(kb, vbuf) do { *(LAS u32x4*)(V_lds + (vbuf) * SHM_V + vst0) = svs0; *(LAS u32x4*)(V_lds + (vbuf) * SHM_V + vst1) = svs1; \
    _Pragma("unroll") for (int _q = 0; _q < NKP; ++_q) *(LAS u32x4*)(K_lds + (kb) * SHM_K + kst + _q * 128) = sks[_q]; } while (0)
    const int NT = seq / KVBLK;
    SLOAD1(0); SWRITE2(0, 0); SLOAD1(KVBLK); __syncthreads();
    bf16x8 pa0 = {}, pa1 = {}, pa2 = {}, pa3 = {};
    int vcur = 0, vprev = 0;
    for (int j = 0; j < NT; ++j) {
        const int kb = j & 1;
        if (lag && j > 0) pv_d0(o, vb0 + (unsigned)(vprev * SHM_V), pa0, pa1, pa2, pa3);
        f32x16 p0, p1; float mn, al;
        qkt<DQK>(p0, p1, K_lds + kb * SHM_K, qr, K_lds, r32, hi);
        partialSM(p0, p1, m_reg, mn, al);
        if (__any(al < 1.f)) { int _t2 = threadIdx.x; asm volatile("" : "+v"(_t2));
            LAS float* _al = (LAS float*)(lds + OFF_WS) + (_t2 >> 6) * 64 + 32; const int _r2 = _t2 & 31, _h2 = (_t2 >> 5) & 1;
            if (_h2 == 0) _al[_r2] = al; asm volatile("s_waitcnt lgkmcnt(0)" ::: "memory");
#pragma unroll
            for (int d = 0; d < 4; ++d)
#pragma unroll
                for (int r = 0; r < 16; ++r) o[d][r] *= _al[crow(r, _h2)]; }
        finishSM(p0, p1, al, l_reg, pa0, pa1, pa2, pa3); SBAR();
        if (!lag) pv_d0(o, vb0 + (unsigned)(vcur * SHM_V), pa0, pa1, pa2, pa3);
        const int vnext = (vcur == 2) ? 0 : vcur + 1;
        if (j + 1 < NT) { SWRITE2(kb ^ 1, vnext); if (j + 2 < NT) SLOAD1((j + 2) * KVBLK); }
        __syncthreads();
        vprev = vcur; vcur = vnext;
    }
    if (lag) pv_d0(o, vb0 + (unsigned)(vprev * SHM_V), pa0, pa1, pa2, pa3);
#undef SLOAD1
#undef SWRITE2
    {
        int t3 = threadIdx.x; asm volatile("" : "+v"(t3));
        const int wid3 = t3 >> 6, r3 = t3 & 31, h3 = (t3 >> 5) & 1, odd = t3 & 1;
        LAS float* li3 = (LAS float*)(lds + OFF_WS) + wid3 * 64;
        if (h3 == 0) li3[r3] = l_reg; asm volatile("s_waitcnt lgkmcnt(0)" ::: "memory");
        float rli[16];
#pragma unroll
        for (int r = 0; r < 16; ++r) rli[r] = __builtin_amdgcn_rcpf(li3[crow(r, h3)]);
        bf16_t* Ow = Ob + (long)(wid3 * QBLK) * ldo + (r3 & ~1);
#pragma unroll
        for (int r = 0; r < 16; r += 2) {
#pragma unroll
            for (int d0 = 0; d0 < 4; ++d0) {
                const float a = o[d0][r] * rli[r], bq = o[d0][r + 1] * rli[r + 1];
                const float xs = odd ? a : bq;
                const float y = __uint_as_float((unsigned)__builtin_amdgcn_update_dpp(0, (int)__float_as_uint(xs), 0xB1, 0xF, 0xF, true));
                const int orow = odd ? crow(r + 1, h3) : crow(r, h3);
                const unsigned w = odd ? cvt_pk_bf16(y, bq) : cvt_pk_bf16(a, y);
                *(unsigned*)(Ow + (long)orow * ldo + d0 * 32) = w;
            }
        }
    }
}
}
namespace ml {
constexpr int PQ = 136;
constexpr int PS = 72;
constexpr int OFF_CH = 4 * 2304 * 4, OFF_Q = OFF_CH + 1024, OFF_K = OFF_Q + 64 * PQ * 2, OFF_V = OFF_K + 64 * PQ * 2, OFF_CT = OFF_V + 64 * PQ * 2, OFF_QK = OFF_CT + 128 * PQ * 2,
              OFF_N = OFF_QK + 64 * PS * 2, OFF_KP = OFF_N + 512, OFF_QN = OFF_KP + 2048, OFF_PS = OFF_QN + 256, LDS_END = OFF_PS + 1024;
static_assert(LDS_END <= LDS_MISC, "mLSTM LDS map");

__device__ __forceinline__ f32x4 mma16(bf16x8 a, bf16x8 b, f32x4 c) { return __builtin_amdgcn_mfma_f32_16x16x32_bf16(a, b, c, 0, 0, 0); }

__device__ __forceinline__ void mlstm_seq(LAS unsigned char* lds, const bf16_t* __restrict__ P, const float* __restrict__ gi, const float* __restrict__ gf, bf16_t* __restrict__ HOUT,
                                          int b, int h, int dir, bool ctx_out) {
    int tid_ = threadIdx.x; asm volatile("" : "+v"(tid_));
    const int tid = tid_, lane = tid & 63, wid = __builtin_amdgcn_readfirstlane(tid >> 6), fr = lane & 15, fq = lane >> 4;
    LAS float* colfac = (LAS float*)lds; LAS float* rowfac = colfac + 2304; LAS float* winter = rowfac + 2304; LAS float* floorv = winter + 2304;
    LAS float* chs = (LAS float*)(lds + OFF_CH);
    LAS bf16_t* Qs = (LAS bf16_t*)(lds + OFF_Q); LAS bf16_t* Ks = (LAS bf16_t*)(lds + OFF_K); LAS bf16_t* Vs = (LAS bf16_t*)(lds + OFF_V);
    LAS bf16_t* Ct = (LAS bf16_t*)(lds + OFF_CT); LAS bf16_t* QKs = (LAS bf16_t*)(lds + OFF_QK);
    LAS float* nvec = (LAS float*)(lds + OFF_N); LAS float* kpart = (LAS float*)(lds + OFF_KP); LAS float* qn = (LAS float*)(lds + OFF_QN); LAS float* psum = (LAS float*)(lds + OFF_PS);

    for (int c = wid; c < 36; c += 8) {
        const int cid = dir ? (c < 4 ? 3 - c : 39 - c) : c;
        const int loc = dir ? 63 - lane : lane;
        const float li = gi[cid * 64 + loc], lf = gf[cid * 64 + loc];
        float bc = lf;
#pragma unroll
        for (int o = 1; o < 64; o <<= 1) { const float t = __shfl_up(bc, o); if (lane >= o) bc += t; }
        const float u = li - bc;
        float pm = u;
#pragma unroll
        for (int o = 1; o < 64; o <<= 1) { const float t = __shfl_up(pm, o); if (lane >= o) pm = fmaxf(pm, t); }
        const float mloc = __shfl(pm, 63), btot = __shfl(bc, 63);
        const int idx = c * 64 + loc;
        colfac[idx] = u; rowfac[idx] = pm; floorv[idx] = bc;
        if (lane == 0) { chs[c] = mloc; chs[36 + c] = btot; }
    }
    __syncthreads();
    if (tid == 0) {
        float m = 0.f;
        for (int c = 0; c < 36; ++c) { const float mloc = chs[c], btot = chs[36 + c], mm = fmaxf(m, mloc);
            chs[72 + c] = m; chs[108 + c] = __expf(m - mm); chs[144 + c] = __expf(mloc - mm); m = btot + mm; }
    }
    __syncthreads();
    for (int i = tid; i < 2304; i += 512) {
        const int c = i >> 6; const float m = chs[72 + c], mloc = chs[c], u = colfac[i], pm = rowfac[i], bc = floorv[i], mx = fmaxf(m, pm);
        colfac[i] = __expf(u - mloc); rowfac[i] = __expf(mloc - mx); winter[i] = __expf(m - mx); floorv[i] = __expf(-bc - mx);
    }
    for (int i = tid; i < 128 * PQ / 2; i += 512) ((LAS unsigned*)Ct)[i] = 0u;
    if (tid < 128) nvec[tid] = 0.f;
    f32x4 Cacc[8];
#pragma unroll
    for (int e = 0; e < 8; ++e) Cacc[e] = (f32x4){0.f, 0.f, 0.f, 0.f};

    const int prr = tid >> 4, pcs = tid & 15;
    u32x4 pre[6];
#define ML_LOAD(cc) do { const int _cid = dir ? ((cc) < 4 ? 3 - (cc) : 39 - (cc)) : (cc); const bf16_t* _base = P + (size_t)(b * TPB + _cid * 64) * NPW + h * 128 + pcs * 8; \
    _Pragma("unroll") for (int _i = 0; _i < 6; ++_i) pre[_i] = *(const u32x4*)(_base + (size_t)(prr + (_i & 1) * 32) * NPW + (_i >> 1) * 512); } while (0)
    ML_LOAD(0);
    const int q4 = (lane & 15) >> 2, p4 = lane & 3;
    const unsigned vs_addr = (unsigned)(uintptr_t)Vs, ks_addr = (unsigned)(uintptr_t)Ks;
    const unsigned trb = (unsigned)(((8 * fq + q4) * PQ + 4 * p4) * 2);
    for (int c = 0; c < 36; ++c) {
        const int cid = dir ? (c < 4 ? 3 - c : 39 - c) : c;
        const int cb = c * 64;
        {
            const float cf0 = colfac[cb + prr], cf1 = colfac[cb + prr + 32];
#pragma unroll
            for (int i = 0; i < 6; ++i) {
                const int rr = prr + (i & 1) * 32; u32x4 w = pre[i];
                if ((i >> 1) == 1) { float f[8]; unpack8(w, f); const float cf = (i & 1) ? cf1 : cf0;
#pragma unroll
                    for (int j = 0; j < 8; ++j) f[j] *= cf;
                    w = pack8(f); }
                LAS bf16_t* dst = ((i >> 1) == 0 ? Qs : (i >> 1) == 1 ? Ks : Vs) + rr * PQ + pcs * 8;
                *(LAS u32x4*)dst = w;
            }
        }
        __syncthreads();
        if (c + 1 < 36) ML_LOAD(c + 1);
        {
            const int sb = wid >> 1, tbase = (wid & 1) * 2;
            bf16x8 ka[4];
#pragma unroll
            for (int ks = 0; ks < 4; ++ks) ka[ks] = *(const LAS bf16x8*)(Ks + (16 * sb + fr) * PQ + ks * 32 + fq * 8);
#pragma unroll
            for (int tt = 0; tt < 2; ++tt) {
                const int tb = tbase + tt; f32x4 acc = (f32x4){0.f, 0.f, 0.f, 0.f};
#pragma unroll
                for (int ks = 0; ks < 4; ++ks) { const bf16x8 qb = *(const LAS bf16x8*)(Qs + (16 * tb + fr) * PQ + ks * 32 + fq * 8); acc = mma16(ka[ks], qb, acc); }
                const int t = 16 * tb + fr, s0 = 16 * sb + 4 * fq; const float rf = rowfac[cb + t];
                float v[4];
#pragma unroll
                for (int i = 0; i < 4; ++i) { const int s = s0 + i; const bool ok = dir ? (s >= t) : (s <= t); v[i] = ok ? acc[i] * rf : 0.f; }
                u32x2 w; w.x = cvt_pk_bf16(v[0], v[1]); w.y = cvt_pk_bf16(v[2], v[3]);
                *(LAS u32x2*)(QKs + t * PS + s0) = w;
                float ps = (v[0] + v[1]) + (v[2] + v[3]); ps += __shfl_xor(ps, 16); ps += __shfl_xor(ps, 32);
                if (fq == 0) psum[sb * 64 + t] = ps;
            }
            { const int t = tid >> 3, part = tid & 7; float s = 0.f;
#pragma unroll
              for (int j = 0; j < 16; ++j) s += __uint_as_float(((unsigned)Qs[t * PQ + part * 16 + j]) << 16) * nvec[part * 16 + j];
              s += __shfl_xor(s, 1); s += __shfl_xor(s, 2); s += __shfl_xor(s, 4);
              if (part == 0) qn[t] = s; }
            { const int d = tid & 127, qq = tid >> 7; float s = 0.f;
#pragma unroll
              for (int j = 0; j < 16; ++j) s += __uint_as_float(((unsigned)Ks[(qq * 16 + j) * PQ + d]) << 16);
              kpart[qq * 128 + d] = s; }
        }
        __syncthreads();
        const float wc = chs[108 + c], sc2 = chs[144 + c];
        {
            const int tb = wid >> 1, eb0 = (wid & 1) * 4;
            f32x4 nacc[4];
#pragma unroll
            for (int j = 0; j < 4; ++j) nacc[j] = (f32x4){0.f, 0.f, 0.f, 0.f};
            bf16x8 qa[4];
#pragma unroll
            for (int ks = 0; ks < 4; ++ks) qa[ks] = *(const LAS bf16x8*)(Qs + (16 * tb + fr) * PQ + ks * 32 + fq * 8);
#pragma unroll
            for (int j = 0; j < 4; ++j)
#pragma unroll
                for (int ks = 0; ks < 4; ++ks) { const bf16x8 cbv = *(const LAS bf16x8*)(Ct + (16 * (eb0 + j) + fr) * PQ + ks * 32 + fq * 8); nacc[j] = mma16(qa[ks], cbv, nacc[j]); }
            float wi[4], inv[4];
#pragma unroll
            for (int i = 0; i < 4; ++i) wi[i] = winter[cb + 16 * tb + 4 * fq + i];
#pragma unroll
            for (int j = 0; j < 4; ++j)
#pragma unroll
                for (int i = 0; i < 4; ++i) nacc[j][i] *= wi[i];
            bf16x8 pa[2];
#pragma unroll
            for (int ks = 0; ks < 2; ++ks) pa[ks] = *(const LAS bf16x8*)(QKs + (16 * tb + fr) * PS + ks * 32 + fq * 8);
            const unsigned vb = vs_addr + trb + (unsigned)(eb0 * 32);
            s16x4 vl[4][2], vh[4][2];
#define ML_TRV(J, KS) vl[J][KS] = tr_read<(KS) * 32 * PQ * 2 + (J) * 32>(vb); vh[J][KS] = tr_read<(KS) * 32 * PQ * 2 + (J) * 32 + 4 * PQ * 2>(vb);
            ML_TRV(0, 0) ML_TRV(0, 1) ML_TRV(1, 0) ML_TRV(1, 1) ML_TRV(2, 0) ML_TRV(2, 1) ML_TRV(3, 0) ML_TRV(3, 1)
#undef ML_TRV
            LGKM0();
#pragma unroll
            for (int j = 0; j < 4; ++j)
#pragma unroll
                for (int ks = 0; ks < 2; ++ks) nacc[j] = mma16(pa[ks], PK8(vl[j][ks], vh[j][ks]), nacc[j]);
#pragma unroll
            for (int i = 0; i < 4; ++i) { const int t = 16 * tb + 4 * fq + i;
                const float den = wi[i] * qn[t] + ((psum[t] + psum[64 + t]) + (psum[128 + t] + psum[192 + t]));
                inv[i] = 1.0f / fmaxf(fabsf(den), floorv[cb + t]); }
            if (ctx_out || cid >= 4) {
                bf16_t* hb = HOUT + (size_t)(b * TPB + cid * 64 + 16 * tb + 4 * fq) * 512 + h * 128 + 16 * eb0 + fr;
#pragma unroll
                for (int j = 0; j < 4; ++j)
#pragma unroll
                    for (int i = 0; i < 4; ++i) { const float hv = nacc[j][i] * inv[i]; hb[(size_t)i * 512 + j * 16] = (bf16_t)(cvt_pk_bf16(hv, hv) & 0xffffu); }
            }
        }
        {
            const unsigned kb = ks_addr + trb + (unsigned)(wid * 32);
            const s16x4 al0 = tr_read<0>(kb), ah0 = tr_read<4 * PQ * 2>(kb), al1 = tr_read<32 * PQ * 2>(kb), ah1 = tr_read<32 * PQ * 2 + 4 * PQ * 2>(kb);
            const unsigned vb = vs_addr + trb;
            s16x4 vl[8][2], vh[8][2];
#define ML_TRV(E, KS) vl[E][KS] = tr_read<(KS) * 32 * PQ * 2 + (E) * 32>(vb); vh[E][KS] = tr_read<(KS) * 32 * PQ * 2 + (E) * 32 + 4 * PQ * 2>(vb);
            ML_TRV(0, 0) ML_TRV(0, 1) ML_TRV(1, 0) ML_TRV(1, 1) ML_TRV(2, 0) ML_TRV(2, 1) ML_TRV(3, 0) ML_TRV(3, 1)
            ML_TRV(4, 0) ML_TRV(4, 1) ML_TRV(5, 0) ML_TRV(5, 1) ML_TRV(6, 0) ML_TRV(6, 1) ML_TRV(7, 0) ML_TRV(7, 1)
#undef ML_TRV
            LGKM0();
            const bf16x8 a0 = PK8(al0, ah0), a1 = PK8(al1, ah1);
#pragma unroll
            for (int e = 0; e < 8; ++e) { f32x4 t4 = (f32x4){0.f, 0.f, 0.f, 0.f};
                t4 = mma16(a0, PK8(vl[e][0], vh[e][0]), t4); t4 = mma16(a1, PK8(vl[e][1], vh[e][1]), t4);
                Cacc[e] = Cacc[e] * wc + t4 * sc2; }
        }
        __syncthreads();
#pragma unroll
        for (int e = 0; e < 8; ++e) { u32x2 w; w.x = cvt_pk_bf16(Cacc[e][0], Cacc[e][1]); w.y = cvt_pk_bf16(Cacc[e][2], Cacc[e][3]);
            *(LAS u32x2*)(Ct + (16 * e + fr) * PQ + 16 * wid + 4 * fq) = w; }
        if (tid < 128) nvec[tid] = wc * nvec[tid] + sc2 * ((kpart[tid] + kpart[128 + tid]) + (kpart[256 + tid] + kpart[384 + tid]));
    }
    __syncthreads();
#undef ML_LOAD
}
}
struct TileOrder {
    int G, c, nM, nN, total, latonly;
    __device__ void init(int nM_, int nN_, int G_, int c_, int latonly_) { nM = nM_; nN = nN_; G = G_; c = c_; total = nM_ * nN_; latonly = latonly_; }
    __device__ bool next(int i, pg8::Unit& u) const {
        const int L = i * G + c; if (L >= total) return false;
        const int gid = L / (8 * nN), rem = L % (8 * nN); int pmi = gid * 8 + (rem & 7); const int pni = rem >> 3;
        if (latonly) pmi = (pmi >> 3) * 9 + 1 + (pmi & 7);
        u.pm = pmi; u.pn = pni; return true;
    }
    __device__ __forceinline__ void a_ready(const pg8::Unit&) const {}
    __device__ __forceinline__ void done(const pg8::Unit&) const {}
};
struct InProjLastOrder {
    int G, c;
    __device__ void init(int G_, int c_) { G = G_; c = c_; }
    __device__ bool next(int i, pg8::Unit& u) const {
        const int L = i * G + c; if (L >= 1216) return false;
        if (L < 1152) { const int gid = L / 144, rem = L % 144, pmi = gid * 8 + (rem & 7); u.pm = (pmi >> 3) * 9 + 1 + (pmi & 7); u.pn = rem >> 3; }
        else { const int j = L - 1152, ci = j >> 3; u.pm = 9 * (j & 7); u.pn = ci < 4 ? 2 + ci : ci < 6 ? 8 + ci : 10 + ci; }
        return true;
    }
    __device__ __forceinline__ void a_ready(const pg8::Unit&) const {}
    __device__ __forceinline__ void done(const pg8::Unit&) const {}
};
struct MoeOrder {
    int G, c, RT, NJ, total;
    __device__ void init(int RT_, int NJ_, int G_, int c_) { RT = RT_; NJ = NJ_; G = G_; c = c_; total = NEXP * RT_ * NJ_; }
    __device__ bool next(int i, pg8::Unit& u) const {
        const int L = i * G + c; if (L >= total) return false;
        const int e = L / (RT * NJ), rem = L % (RT * NJ);
        int ii, j; if (MOE_ORDER_ALT) { const int jb = rem / (RT * 4), r2 = rem % (RT * 4); j = jb * 4 + (r2 & 3); ii = r2 >> 2; } else { ii = rem % RT; j = rem / RT; }
        u.pm = e * RT + ii; u.pn = e * NJ + j; return true;
    }
    __device__ __forceinline__ void a_ready(const pg8::Unit&) const {}
    __device__ __forceinline__ void done(const pg8::Unit&) const {}
};
typedef const f32x4 (&AccRef)[2][2][4][2];
struct EpiInProj {
    static constexpr bool PERM = true, AFTER_DRAIN = false;
    bf16_t* P; float* PG;
    __device__ __forceinline__ void operator()(AccRef acc, const pg8::Unit& u, int wr, int wc, int fr, int fq) const {
        const int row0 = u.pm * 256 + wr * 64 + fr;
        if (u.pn < 17) {
            const int col0 = u.pn * 256 + wc * 32 + 8 * fq;
#pragma unroll
            for (int ai = 0; ai < 2; ++ai)
#pragma unroll
                for (int m = 0; m < 4; ++m) { bf16_t* rowp = P + (size_t)(row0 + ai * 128 + m * 16) * NPW + col0;
#pragma unroll
                    for (int bj = 0; bj < 2; ++bj) { const f32x4 v0 = acc[ai][bj][m][0], v1 = acc[ai][bj][m][1];
                        u32x4 w; w.x = cvt_pk_bf16(v0[0], v0[1]); w.y = cvt_pk_bf16(v0[2], v0[3]); w.z = cvt_pk_bf16(v1[0], v1[1]); w.w = cvt_pk_bf16(v1[2], v1[3]);
                        *(u32x4*)(rowp + bj * 128) = w; } }
        } else {
            const int col0 = wc * 32 + 8 * fq;
#pragma unroll
            for (int ai = 0; ai < 2; ++ai)
#pragma unroll
                for (int m = 0; m < 4; ++m) { float* rowp = PG + (size_t)(row0 + ai * 128 + m * 16) * 128 + col0;
                    *(f32x4*)(rowp) = acc[ai][0][m][0]; *(f32x4*)(rowp + 4) = acc[ai][0][m][1]; }
        }
    }
};
struct EpiBf16Store {
    static constexpr bool PERM = true, AFTER_DRAIN = false;
    bf16_t* O; int ldc;
    __device__ __forceinline__ void operator()(AccRef acc, const pg8::Unit& u, int wr, int wc, int fr, int fq) const {
        const int row0 = u.pm * 256 + wr * 64 + fr, col0 = u.pn * 256 + wc * 32 + 8 * fq;
#pragma unroll
        for (int ai = 0; ai < 2; ++ai)
#pragma unroll
            for (int m = 0; m < 4; ++m) { bf16_t* rowp = O + (size_t)(row0 + ai * 128 + m * 16) * ldc + col0;
#pragma unroll
                for (int bj = 0; bj < 2; ++bj) { const f32x4 v0 = acc[ai][bj][m][0], v1 = acc[ai][bj][m][1];
                    u32x4 w; w.x = cvt_pk_bf16(v0[0], v0[1]); w.y = cvt_pk_bf16(v0[2], v0[3]); w.z = cvt_pk_bf16(v1[0], v1[1]); w.w = cvt_pk_bf16(v1[2], v1[3]);
                    *(u32x4*)(rowp + bj * 128) = w; } }
    }
};
struct EpiOutProj {
    static constexpr bool PERM = false, AFTER_DRAIN = false;
    float* X; const float* g1;
    const float* xin; const float* cin;
    __device__ __forceinline__ void operator()(AccRef acc, const pg8::Unit& u, int wr, int wc, int fr, int fq) const {
        const int row0 = u.pm * 256 + wr * 64 + fr, col0 = u.pn * 256 + wc * 32 + 4 * fq;
        const int bb = u.pm / 9, ti = u.pm % 9, mr = (ti == 0) ? 8 : bb;
        const float* g = g1 + (size_t)mr * 12288 + col0;
        const float* src = xin ? (ti == 0 ? cin + ((size_t)bb * 256 + wr * 64 + fr) * DM : xin + ((size_t)bb * 2048 + (ti - 1) * 256 + wr * 64 + fr) * DM) + col0
                               : X + (size_t)row0 * DM + col0;
        f32x4 gv[2][2];
#pragma unroll
        for (int bj = 0; bj < 2; ++bj)
#pragma unroll
            for (int n = 0; n < 2; ++n) gv[bj][n] = *(const f32x4*)(g + bj * 128 + n * 16);
#pragma unroll
        for (int ai = 0; ai < 2; ++ai)
#pragma unroll
            for (int m = 0; m < 4; ++m) { float* rowp = X + (size_t)(row0 + ai * 128 + m * 16) * DM + col0; const float* sp = src + (size_t)(ai * 128 + m * 16) * DM;
#pragma unroll
                for (int bj = 0; bj < 2; ++bj)
#pragma unroll
                    for (int n = 0; n < 2; ++n) { f32x4 xv = *(const f32x4*)(sp + bj * 128 + n * 16); xv += gv[bj][n] * acc[ai][bj][m][n]; *(f32x4*)(rowp + bj * 128 + n * 16) = xv; } }
    }
};
struct EpiSwiGLU {
    static constexpr bool PERM = true, AFTER_DRAIN = false;
    bf16_t* ACT; int NJ;
    __device__ __forceinline__ void operator()(AccRef acc, const pg8::Unit& u, int wr, int wc, int fr, int fq) const {
        const int row0 = u.pm * 256 + wr * 64 + fr, j = u.pn % NJ, col0 = j * 128 + wc * 32 + 8 * fq;
#pragma unroll
        for (int ai = 0; ai < 2; ++ai)
#pragma unroll
            for (int m = 0; m < 4; ++m) { bf16_t* rowp = ACT + (size_t)(row0 + ai * 128 + m * 16) * 2048 + col0;
                float a[8];
#pragma unroll
                for (int n = 0; n < 2; ++n)
#pragma unroll
                    for (int q = 0; q < 4; ++q) { const float gt = acc[ai][0][m][n][q], up = acc[ai][1][m][n][q];
                        a[n * 4 + q] = gt * __builtin_amdgcn_rcpf(1.0f + __expf(-gt)) * up; }
                *(u32x4*)rowp = pack8(a); }
    }
};
struct EpiDown {
    static constexpr bool PERM = true, AFTER_DRAIN = false;
    bf16_t* Y; const float* gv; int NJ;
    __device__ __forceinline__ void operator()(AccRef acc, const pg8::Unit& u, int wr, int wc, int fr, int fq) const {
        const int row0 = u.pm * 256 + wr * 64 + fr, j = u.pn % NJ, col0 = j * 256 + wc * 32 + 8 * fq;
#pragma unroll
        for (int ai = 0; ai < 2; ++ai)
#pragma unroll
            for (int m = 0; m < 4; ++m) { const int row = row0 + ai * 128 + m * 16; const float g = gv[row]; bf16_t* rowp = Y + (size_t)row * 2048 + col0;
#pragma unroll
                for (int bj = 0; bj < 2; ++bj) { const f32x4 v0 = acc[ai][bj][m][0] * g, v1 = acc[ai][bj][m][1] * g;
                    u32x4 w; w.x = cvt_pk_bf16(v0[0], v0[1]); w.y = cvt_pk_bf16(v0[2], v0[3]); w.z = cvt_pk_bf16(v1[0], v1[1]); w.w = cvt_pk_bf16(v1[2], v1[3]);
                    *(u32x4*)(rowp + bj * 128) = w; } }
    }
};

struct Frame {
    LAS unsigned char* lds; __attribute__((address_space(1))) unsigned char* ws; int tid, lane, wid, bid, G, vcu;
    __device__ __forceinline__ float* MOD() const { return (float*)(ws + WS_MOD); }
    __device__ __forceinline__ float* ROPEG() const { return (float*)(ws + WS_ROPEG); }
    __device__ __forceinline__ float* ROPEM() const { return (float*)(ws + WS_ROPEM); }
    __device__ __forceinline__ float* GI() const { return (float*)(ws + WS_GI); }
    __device__ __forceinline__ float* GF() const { return (float*)(ws + WS_GF); }
    __device__ __forceinline__ float* AFF() const { return (float*)(ws + WS_AFF); }
    __device__ __forceinline__ int* PTOK() const { return (int*)(ws + WS_PTOK); }
    __device__ __forceinline__ float* PGV() const { return (float*)(ws + WS_PGV); }
    __device__ __forceinline__ int* TOKSLOT() const { return (int*)(ws + WS_TOKSLOT); }
    __device__ __forceinline__ bf16_t* WIN() const { return (bf16_t*)(ws + WS_WIN); }
    __device__ __forceinline__ bf16_t* WOUT() const { return (bf16_t*)(ws + WS_WOUT); }
    __device__ __forceinline__ bf16_t* WUQ() const { return (bf16_t*)(ws + WS_WUQ); }
    __device__ __forceinline__ bf16_t* WUKV() const { return (bf16_t*)(ws + WS_WUKV); }
    __device__ __forceinline__ bf16_t* WGU() const { return (bf16_t*)(ws + WS_WGU); }
    __device__ __forceinline__ bf16_t* WD() const { return (bf16_t*)(ws + WS_WD); }
    __device__ __forceinline__ float* X() const { return (float*)(ws + WS_X); }
    __device__ __forceinline__ bf16_t* H() const { return (bf16_t*)(ws + WS_H); }
    __device__ __forceinline__ bf16_t* P() const { return (bf16_t*)(ws + WS_P); }
    __device__ __forceinline__ float* PG() const { return (float*)(ws + WS_PG); }
    __device__ __forceinline__ bf16_t* QG() const { return (bf16_t*)(ws + WS_QG); }
    __device__ __forceinline__ bf16_t* KG() const { return (bf16_t*)(ws + WS_KG); }
    __device__ __forceinline__ bf16_t* QA() const { return (bf16_t*)(ws + WS_QA); }
    __device__ __forceinline__ bf16_t* KVA() const { return (bf16_t*)(ws + WS_KVA); }
    __device__ __forceinline__ bf16_t* MQ() const { return (bf16_t*)(ws + WS_MQ); }
    __device__ __forceinline__ bf16_t* MKV() const { return (bf16_t*)(ws + WS_MKV); }
    __device__ __forceinline__ bf16_t* QM() const { return (bf16_t*)(ws + WS_QM); }
    __device__ __forceinline__ bf16_t* KM() const { return (bf16_t*)(ws + WS_KM); }
    __device__ __forceinline__ float* HF() const { return (float*)(ws + WS_HF); }
    __device__ __forceinline__ float* HB() const { return (float*)(ws + WS_HB); }
    __device__ __forceinline__ bf16_t* MIX() const { return (bf16_t*)(ws + WS_MIX); }
    __device__ __forceinline__ bf16_t* XG() const { return (bf16_t*)(ws + WS_XG); }
    __device__ __forceinline__ bf16_t* ACT() const { return (bf16_t*)(ws + WS_ACT); }
    __device__ __forceinline__ bf16_t* Y() const { return (bf16_t*)(ws + WS_Y); }
    __device__ __forceinline__ unsigned* ctl() const { return (unsigned*)(ws + WS_CTL); }
};
__device__ __forceinline__ Frame fresh(const Frame& F0) {
    Frame F = F0; int t = threadIdx.x; asm volatile("" : "+v"(t)); F.tid = t; F.lane = t & 63; F.wid = __builtin_amdgcn_readfirstlane(t >> 6);
    __attribute__((address_space(1))) unsigned char* w = F0.ws; asm volatile("" : "+s"(w)); F.ws = w; return F;
}

constexpr int CVT_SPL = 1668, CVT_NS = 2 * CVT_SPL;
struct CvtStrip { const float* sp; bf16_t* dq; int ld, K, nk; float sc; };
__device__ __forceinline__ CvtStrip cvt_strip(const Params& p, const Frame& F, int s) {
    const int c4 = (F.tid & 15) * 4, r4 = (F.tid >> 4) * 4, nl = F.tid >> 3, seg = F.tid & 7;
    const int l = s / CVT_SPL; int v = s % CVT_SPL;
    const float* src; bf16_t* dst; int ld, K, col; float scl = 1.f;
    if (v < 72) { K = 2048; src = p.w_in + (size_t)l * 2048 * 4432; ld = 4432; dst = F.WIN() + ((size_t)l * NPW + v * 64) * 2048;
        const int n = v * 64 + c4; col = n < 2048 ? n : n < 4352 ? n + 16 : n < 4368 ? n - 2304 : n < 4432 ? n : -1;
        if (col >= 512 && col < 1024) scl = 0.08838834764831845f; }
    else if (v < 104) { v -= 72; K = 2048; src = p.w_out + (size_t)l * 2048 * 2048; ld = 2048; dst = F.WOUT() + ((size_t)l * 2048 + v * 64) * 2048; col = v * 64 + c4; }
    else if (v < 116) { v -= 104; K = 512; src = p.mla_w_uq + (size_t)l * 512 * 768; ld = 768; dst = F.WUQ() + ((size_t)l * 768 + v * 64) * 512; col = v * 64 + c4; }
    else if (v < 132) { v -= 116; K = 256; src = p.mla_w_ukv + (size_t)l * 256 * 1024; ld = 1024; dst = F.WUKV() + ((size_t)l * 1024 + v * 64) * 256; col = v * 64 + c4; }
    else if (v < 1156) { v -= 132; K = 2048; const int e = v >> 6, rr = (v & 63) * 64, bj = (rr >> 7) & 1;
        src = (bj ? p.w_up : p.w_gate) + (size_t)(l * 16 + e) * 2048 * 2048; ld = 2048; dst = F.WGU() + ((size_t)(l * 16 + e) * 4096 + rr) * 2048; col = (rr >> 8) * 128 + (rr & 127) + c4; }
    else { v -= 1156; K = 2048; const int e = v >> 5, rr = (v & 31) * 64;
        src = p.w_down + (size_t)(l * 16 + e) * 2048 * 2048; ld = 2048; dst = F.WD() + ((size_t)(l * 16 + e) * 2048 + rr) * 2048; col = rr + c4; }
    CvtStrip d; d.sp = src + (size_t)r4 * ld + (col >= 0 ? col : 0); d.dq = dst + (size_t)nl * K + seg * 16; d.ld = ld; d.K = K; d.nk = K >> 7; d.sc = col >= 0 ? scl : 0.f; return d;
}
__device__ __forceinline__ void cvt_issue(const CvtStrip& d, int kt, f32x4 (&v)[4]) {
    const float* q = d.sp + (size_t)(kt * 128) * d.ld;
#pragma unroll
    for (int i = 0; i < 4; ++i) v[i] = CVT_NT_LOADS ? __builtin_nontemporal_load((const f32x4*)(q + (size_t)i * d.ld)) : *(const f32x4*)(q + (size_t)i * d.ld);
}
constexpr int CVT_PB = 264, CVT_TB = 64 * CVT_PB;
__device__ __forceinline__ void cvt_finish(const Frame& F, const CvtStrip& d, int kt, const f32x4 (&v)[4], LAS unsigned char* T) {
    const int tid = F.tid; const float sc = d.sc;
    LAS unsigned char* wp = T + ((tid & 15) * 4) * CVT_PB + (tid >> 4) * 8;
#pragma unroll
    for (int q = 0; q < 4; ++q) { u32x2 w; w.x = cvt_pk_bf16(v[0][q] * sc, v[1][q] * sc); w.y = cvt_pk_bf16(v[2][q] * sc, v[3][q] * sc); *(LAS u32x2*)(wp + q * CVT_PB) = w; }
    __syncthreads();
    { const LAS unsigned char* rp = T + (tid >> 3) * CVT_PB + (tid & 7) * 32;
      const u32x2 a = *(const LAS u32x2*)rp, b2 = *(const LAS u32x2*)(rp + 8), c = *(const LAS u32x2*)(rp + 16), e = *(const LAS u32x2*)(rp + 24);
      bf16_t* dq = d.dq + kt * 128;
      *(u32x4*)dq = (u32x4){a.x, a.y, b2.x, b2.y}; *(u32x4*)(dq + 8) = (u32x4){c.x, c.y, e.x, e.y}; }
}
constexpr int CVT_A0 = 132, CVT_A1 = CVT_A0 + CVT_NA, CVT_B0 = CVT_A1, CVT_B1 = CVT_B0 + CVT_NB, CVT_C0 = CVT_SPL, CVT_C1 = CVT_C0 + 132 + CVT_NC, CVT_D1 = CVT_NS, CVT_D0 = CVT_D1 - CVT_ND;
static_assert(CVT_B1 <= 1156 && CVT_C1 <= CVT_SPL + 1156 && CVT_D0 >= CVT_SPL + 1156, "side ranges");
__device__ __forceinline__ void cvt_loop(const Params& p, const Frame& F, int w, int nw, int s0, int s1) {
    LAS unsigned char* T0 = F.lds; LAS unsigned char* T1 = F.lds + CVT_TB;
    f32x4 v0[4], v1[4], v2[4], v3[4], v4[4];
    int sI = s0 + w, ktI = 0, sF = sI, ktF = 0; bool iv = sI < s1;
    __syncthreads();
    if (!iv) return;
    CvtStrip dI = cvt_strip(p, F, sI), dF = dI;
#define CVT_ADV_I() do { if (++ktI == dI.nk) { sI += nw; ktI = 0; iv = sI < s1; if (iv) dI = cvt_strip(p, F, sI); } } while (0)
#define CVT_STEP(VI, VF, TB) { if (iv) { cvt_issue(dI, ktI, VI); CVT_ADV_I(); } \
        cvt_finish(F, dF, ktF, VF, TB); if (++ktF == dF.nk) { sF += nw; ktF = 0; if (sF >= s1) break; dF = cvt_strip(p, F, sF); } }
    cvt_issue(dI, ktI, v0); CVT_ADV_I();
    if (iv) { cvt_issue(dI, ktI, v1); CVT_ADV_I(); }
    if (iv) { cvt_issue(dI, ktI, v2); CVT_ADV_I(); }
    if (iv) { cvt_issue(dI, ktI, v3); CVT_ADV_I(); }
    for (;;) { CVT_STEP(v4, v0, T0) CVT_STEP(v0, v1, T1) CVT_STEP(v1, v2, T0) CVT_STEP(v2, v3, T1) CVT_STEP(v3, v4, T0)
               CVT_STEP(v4, v0, T1) CVT_STEP(v0, v1, T0) CVT_STEP(v1, v2, T1) CVT_STEP(v2, v3, T0) CVT_STEP(v3, v4, T1) }
#undef CVT_STEP
#undef CVT_ADV_I
    __syncthreads();
}
__device__ __forceinline__ int pro_total(int sm, int mq0, int mq1) { return CVT_A0 + ((sm & 1) ? 0 : CVT_NA) + ((sm & 2) ? 0 : CVT_NB) + (CVT_C0 - CVT_B1 - mq0) + ((sm & 4) ? 0 : CVT_C1 - CVT_C0) + (CVT_D0 - CVT_C1 - mq1) + ((sm & 8) ? 0 : CVT_D1 - CVT_D0); }
__device__ __forceinline__ int pro_map(int v, int sm, int mq0, int mq1) {
    int s = v;
    if (s < CVT_A0) return s;
    if (sm & 1) s += CVT_NA; else if (s < CVT_A1) return s;
    if (sm & 2) s += CVT_NB; else if (s < CVT_B1) return s;
    if (s < CVT_C0 - mq0) return s;
    s += mq0;
    if (sm & 4) s += CVT_C1 - CVT_C0; else if (s < CVT_C1) return s;
    if (s < CVT_D0 - mq1) return s;
    s += mq1;
    if (sm & 8) s += CVT_D1 - CVT_D0;
    return s;
}
template <bool MAP>
__device__ __forceinline__ void cvt_loop8(const Params& p, const Frame& F, int w, int nw, int s0, int s1, int sm = 0, int mq0 = 0, int mq1 = 0) {
    LAS unsigned char* T0 = F.lds; LAS unsigned char* T1 = F.lds + CVT_TB;
    f32x4 v0[4], v1[4], v2[4], v3[4], v4[4], v5[4], v6[4], v7[4], v8[4];
    int sI = s0 + w, ktI = 0, sF = sI, ktF = 0; bool iv = sI < s1;
    __syncthreads();
    if (!iv) return;
    CvtStrip dI = cvt_strip(p, F, MAP ? pro_map(sI, sm, mq0, mq1) : sI), dF = dI;
#define CVT_ADV_I() do { if (++ktI == dI.nk) { sI += nw; ktI = 0; iv = sI < s1; if (iv) dI = cvt_strip(p, F, MAP ? pro_map(sI, sm, mq0, mq1) : sI); } } while (0)
#define CVT_STEP(VI, VF, TB) { if (iv) { cvt_issue(dI, ktI, VI); CVT_ADV_I(); } \
        cvt_finish(F, dF, ktF, VF, TB); if (++ktF == dF.nk) { sF += nw; ktF = 0; if (sF >= s1) break; dF = cvt_strip(p, F, MAP ? pro_map(sF, sm, mq0, mq1) : sF); } }
    cvt_issue(dI, ktI, v0); CVT_ADV_I();
    if (iv) { cvt_issue(dI, ktI, v1); CVT_ADV_I(); }
    if (iv) { cvt_issue(dI, ktI, v2); CVT_ADV_I(); }
    if (iv) { cvt_issue(dI, ktI, v3); CVT_ADV_I(); }
    if (iv) { cvt_issue(dI, ktI, v4); CVT_ADV_I(); }
    if (iv) { cvt_issue(dI, ktI, v5); CVT_ADV_I(); }
    if (iv) { cvt_issue(dI, ktI, v6); CVT_ADV_I(); }
    if (iv) { cvt_issue(dI, ktI, v7); CVT_ADV_I(); }
    for (;;) { CVT_STEP(v8, v0, T0) CVT_STEP(v0, v1, T1) CVT_STEP(v1, v2, T0) CVT_STEP(v2, v3, T1) CVT_STEP(v3, v4, T0) CVT_STEP(v4, v5, T1) CVT_STEP(v5, v6, T0) CVT_STEP(v6, v7, T1) CVT_STEP(v7, v8, T0) CVT_STEP(v8, v0, T1) CVT_STEP(v0, v1, T0) CVT_STEP(v1, v2, T1) CVT_STEP(v2, v3, T0) CVT_STEP(v3, v4, T1) CVT_STEP(v4, v5, T0) CVT_STEP(v5, v6, T1) CVT_STEP(v6, v7, T0) CVT_STEP(v7, v8, T1) }
#undef CVT_STEP
#undef CVT_ADV_I
    __syncthreads();
}
__device__ __forceinline__ void cvt_item(const Params& p, const Frame& F, int s, int h) {
    LAS unsigned char* T0 = F.lds; LAS unsigned char* T1 = F.lds + CVT_TB;
    const CvtStrip d = cvt_strip(p, F, s); const int k0 = 8 * h;
    f32x4 v0[4], v1[4], v2[4], v3[4];
    cvt_issue(d, k0, v0); cvt_issue(d, k0 + 1, v1); cvt_issue(d, k0 + 2, v2); cvt_issue(d, k0 + 3, v3);
    cvt_finish(F, d, k0, v0, T0); cvt_issue(d, k0 + 4, v0);
    cvt_finish(F, d, k0 + 1, v1, T1); cvt_issue(d, k0 + 5, v1);
    cvt_finish(F, d, k0 + 2, v2, T0); cvt_issue(d, k0 + 6, v2);
    cvt_finish(F, d, k0 + 3, v3, T1); cvt_issue(d, k0 + 7, v3);
    cvt_finish(F, d, k0 + 4, v0, T0); cvt_finish(F, d, k0 + 5, v1, T1); cvt_finish(F, d, k0 + 6, v2, T0); cvt_finish(F, d, k0 + 7, v3, T1);
}
__device__ __forceinline__ void ph_convert_side(const Params& p, const Frame& F0, int ngx, int t0, int t1) {
    const Frame F = fresh(F0);
    int xcd = F.bid & 7, lid = F.bid >> 3, per = F.G >> 3;
    int w = xcd * (per - ngx) + (lid - ngx), nw = 8 * (per - ngx);
    asm volatile("" : "+s"(w), "+s"(nw), "+s"(t0), "+s"(t1));
    if (CVT_SIDE8) cvt_loop8<false>(p, F, w, nw, t0, t1); else cvt_loop(p, F, w, nw, t0, t1);
}
__device__ __forceinline__ void ph_prologue(const Params& p, const Frame& F0) { const Frame F = fresh(F0);
    const int tid = F.tid, lane = F.lane, wid = F.wid;
    {
        LAS float* S = (LAS float*)F.lds; LAS float* R = (LAS float*)(F.lds + 9 * 2048 * 4);
        for (int i = tid; i < 9 * 2048; i += 512) { const int r = i >> 11, k = i & 2047; const float v = r < 8 ? p.c[r * 2048 + k] : p.c_ctx[k]; S[i] = v / (1.0f + expf(-v)); }
        __syncthreads();
        const bool psplit = PRO_SPLIT > 0 && F.G == 256; const bool ada = !psplit || ((F.bid >> 3) & 1) == 0;
        const int ia = psplit ? (F.bid >> 4) * 8 + (F.bid & 7) : F.bid, na = psplit ? 128 : F.G;
        if (ada)
        for (int it = ia; it < 768; it += na) {
            const int l = it / 384, n0 = (it % 384) * 32, col = lane & 31, ksub = lane >> 5;
            const float* W = p.ada_w + (size_t)l * 2048 * 12288 + n0 + col;
            float acc[9];
#pragma unroll
            for (int r = 0; r < 9; ++r) acc[r] = 0.f;
            const int k0 = wid * 256 + ksub * 128;
            for (int kb = 0; kb < 128; kb += 32) {
                float wv[32];
#pragma unroll
                for (int kk = 0; kk < 32; ++kk) wv[kk] = __builtin_nontemporal_load(W + (size_t)(k0 + kb + kk) * 12288);
#pragma unroll
                for (int kk = 0; kk < 32; ++kk) { const int k = k0 + kb + kk;
#pragma unroll
                    for (int r = 0; r < 9; ++r) acc[r] += S[r * 2048 + k] * wv[kk]; } }
#pragma unroll
            for (int r = 0; r < 9; ++r) R[((wid * 2 + ksub) * 9 + r) * 32 + col] = acc[r];
            __syncthreads();
            for (int i = tid; i < 9 * 32; i += 512) { const int r = i >> 5, n = i & 31; float s = 0.f;
#pragma unroll
                for (int q = 0; q < 16; ++q) s += R[(q * 9 + r) * 32 + n];
                F.MOD()[((size_t)l * 9 + r) * 12288 + n0 + n] = s + p.ada_b[l * 12288 + n0 + n]; }
            __syncthreads();
        }
    }
    for (int i = F.bid * 512 + tid; i < 2048 * 64; i += F.G * 512) { const int n = i >> 6, j = i & 63, row = n >> 6, colp = n & 63;
        const float inv = powf(10000.0f, -(float)(j & 31) / 32.0f), ang = (float)(j < 32 ? row : colp) * inv;
        F.ROPEG()[i] = cosf(ang); F.ROPEG()[2048 * 64 + i] = sinf(ang); }
    for (int i = F.bid * 512 + tid; i < 2048 * 32; i += F.G * 512) { const int n = i >> 5, j = i & 31, row = n >> 6, colp = n & 63;
        const float inv = powf(10000.0f, -(float)(j & 15) / 16.0f), ang = (float)(j < 16 ? row : colp) * inv;
        F.ROPEM()[i] = cosf(ang); F.ROPEM()[2048 * 32 + i] = sinf(ang); }
    __syncthreads();
    const int sm = (F.G == 256) ? SIDE_MASK : 0;
    const int mq0 = (F.G == 256) ? CVT_MQ0 : 0, mq1 = (F.G == 256) ? CVT_MQ1 + CVT_TKQ : 0;
    if (PRO_SPLIT > 0 && F.G == 256) {
        if (((F.bid >> 3) & 1) != 0) cvt_loop8<true>(p, F, (F.bid >> 4) * 8 + (F.bid & 7), 128, 0, PRO_SPLIT, sm, mq0, mq1);
        cvt_loop8<true>(p, F, F.bid, F.G, PRO_SPLIT, pro_total(sm, mq0, mq1), sm, mq0, mq1);
    } else
    cvt_loop8<true>(p, F, F.bid, F.G, 0, pro_total(sm, mq0, mq1), sm, mq0, mq1);
    if (false) {
        cvt_loop(p, F, F.bid, F.G, 0, CVT_A0);
        if (!(sm & 1)) cvt_loop(p, F, F.bid, F.G, CVT_A0, CVT_A1);
        if (!(sm & 2)) cvt_loop(p, F, F.bid, F.G, CVT_B0, CVT_B1);
        cvt_loop(p, F, F.bid, F.G, CVT_B1, CVT_C0);
        if (!(sm & 4)) cvt_loop(p, F, F.bid, F.G, CVT_C0, CVT_C1);
        cvt_loop(p, F, F.bid, F.G, CVT_C1, CVT_D0);
        if (!(sm & 8)) cvt_loop(p, F, F.bid, F.G, CVT_D0, CVT_D1);
    }
}

struct N1Row { f32x4 xv[8]; int sv; };
__device__ __forceinline__ N1Row n1_load(const Params& p, const Frame& F, int r, int mode, int lane) {
    N1Row x; const int b = r / TPB, t = r % TPB;
    const float* src = (mode == 0) ? (t < 256 ? p.ctx + ((size_t)b * 256 + t) * DM : p.x + ((size_t)b * 2048 + (t - 256)) * DM) : F.X() + (size_t)r * DM;
#pragma unroll
    for (int i = 0; i < 8; ++i) x.xv[i] = *(const f32x4*)(src + (i * 64 + lane) * 4);
    x.sv = (mode != 0 && lane < 16) ? F.TOKSLOT()[(size_t)r * 16 + lane] : -1;
    return x;
}
__device__ __forceinline__ void n1_combine(const Frame& F, N1Row& x, int r, int lp, int lane) {
    const int b = r / TPB, t = r % TPB, mr = t < 256 ? 8 : b;
    const float* g2 = F.MOD() + ((size_t)lp * 9 + mr) * 12288 + 5 * 2048;
    f32x4 ac[8];
#pragma unroll
    for (int i = 0; i < 8; ++i) ac[i] = (f32x4){0.f, 0.f, 0.f, 0.f};
    unsigned long long mask = __ballot(x.sv >= 0);
    while (mask) {
        const int e0 = __builtin_ctzll(mask); mask &= mask - 1;
        const bool two = mask != 0ull; const int e1 = two ? __builtin_ctzll(mask) : e0; if (two) mask &= mask - 1;
        const int s0 = __builtin_amdgcn_readlane(x.sv, e0), s1 = __builtin_amdgcn_readlane(x.sv, e1);
        const bf16_t* y0 = F.Y() + (size_t)s0 * 2048 + lane * 4; const bf16_t* y1 = F.Y() + (size_t)s1 * 2048 + lane * 4;
        u32x2 w0[8], w1[8];
#pragma unroll
        for (int i = 0; i < 8; ++i) { w0[i] = *(const u32x2*)(y0 + i * 256); w1[i] = *(const u32x2*)(y1 + i * 256); }
#pragma unroll
        for (int i = 0; i < 8; ++i) { ac[i] += (f32x4){bflo(w0[i].x), bfhi(w0[i].x), bflo(w0[i].y), bfhi(w0[i].y)};
            if (two) ac[i] += (f32x4){bflo(w1[i].x), bfhi(w1[i].x), bflo(w1[i].y), bfhi(w1[i].y)}; }
    }
#pragma unroll
    for (int i = 0; i < 8; ++i) x.xv[i] += *(const f32x4*)(g2 + (i * 64 + lane) * 4) * ac[i];
}
__device__ __forceinline__ void n1_finish(const Params& p, const Frame& F, const N1Row& x, int r, int l, int mode, int lane) {
    const int b = r / TPB, t = r % TPB, mr = t < 256 ? 8 : b;
    if (mode == 2) { float* dst = p.out + ((size_t)b * 2048 + (t - 256)) * DM;
#pragma unroll
        for (int i = 0; i < 8; ++i) *(f32x4*)(dst + (i * 64 + lane) * 4) = x.xv[i];
        return; }
    if (mode != 0) { float* dst = F.X() + (size_t)r * DM;
#pragma unroll
      for (int i = 0; i < 8; ++i) *(f32x4*)(dst + (i * 64 + lane) * 4) = x.xv[i]; }
    float ss = 0.f;
#pragma unroll
    for (int i = 0; i < 8; ++i) ss += (x.xv[i][0] * x.xv[i][0] + x.xv[i][1] * x.xv[i][1]) + (x.xv[i][2] * x.xv[i][2] + x.xv[i][3] * x.xv[i][3]);
    ss = wsum64(ss);
    const float rstd = 1.0f / sqrtf(ss * (1.0f / DM) + EPSN);
    const float* md = F.MOD() + ((size_t)l * 9 + mr) * 12288; const float* nw = p.norm1 + (size_t)l * DM;
    bf16_t* hp = F.H() + (size_t)r * DM;
#pragma unroll
    for (int i = 0; i < 8; ++i) { const int d = (i * 64 + lane) * 4;
        const f32x4 g = *(const f32x4*)(nw + d), sh = *(const f32x4*)(md + d), sc = *(const f32x4*)(md + 2048 + d);
        const f32x4 hv = x.xv[i] * rstd * g * (sc + 1.0f) + sh;
        u32x2 w; w.x = cvt_pk_bf16(hv[0], hv[1]); w.y = cvt_pk_bf16(hv[2], hv[3]); *(u32x2*)(hp + d) = w; }
}
template <int MODE, int PF>
__device__ __forceinline__ void ph_norm1_t(const Params& p, const Frame& F0, int l) { const Frame F = fresh(F0);
    constexpr int mode = MODE;
    const int lane = F.lane, st = F.G * 8; const int lp = (mode == 2) ? l : l - 1;
    int r = F.bid * 8 + F.wid;
    N1Row a = n1_load(p, F, r < NTOK ? r : 0, mode, lane), b2 = n1_load(p, F, (r + st < NTOK) ? r + st : 0, mode, lane);
    for (; r < NTOK; r += 2 * st) {
        const int r2 = r + st, rn = r + 2 * st, rn2 = r + 3 * st; const bool has2 = r2 < NTOK;
        N1Row an, bn; if constexpr (PF >= 1) an = n1_load(p, F, rn < NTOK ? rn : 0, mode, lane);
        if constexpr (PF >= 2) bn = n1_load(p, F, rn2 < NTOK ? rn2 : 0, mode, lane);
        const bool ok1 = !(mode == 2 && (r % TPB) < 256), ok2 = has2 && !(mode == 2 && (r2 % TPB) < 256);
        if (mode != 0) { if (ok1) n1_combine(F, a, r, lp, lane); if (ok2) n1_combine(F, b2, r2, lp, lane); }
        if (ok1) n1_finish(p, F, a, r, l, mode, lane);
        if (ok2) n1_finish(p, F, b2, r2, l, mode, lane);
        if constexpr (PF < 1) an = n1_load(p, F, rn < NTOK ? rn : 0, mode, lane);
        if constexpr (PF < 2) bn = n1_load(p, F, rn2 < NTOK ? rn2 : 0, mode, lane);
        a = an; b2 = bn;
    }
}
__device__ __forceinline__ void ph_norm1(const Params& p, const Frame& F0, int l, int mode) {
    if (mode == 0) ph_norm1_t<0, 2>(p, F0, l); else if (mode == 1) ph_norm1_t<1, 0>(p, F0, l); else ph_norm1_t<2, 1>(p, F0, l);
}

struct PrepRow { u32x4 q0, q1, kk, qa; float gate; };
__device__ __forceinline__ PrepRow prep_load(const Frame& F, int r, int lane) {
    const bf16_t* prow = F.P() + (size_t)r * NPW; PrepRow x;
    x.q0 = *(const u32x4*)(prow + 2048 + lane * 8); x.q1 = *(const u32x4*)(prow + 2560 + lane * 8);
    x.kk = *(const u32x4*)(prow + (lane < 32 ? 3072 + lane * 8 : 4096 + (lane - 32) * 8));
    x.qa = *(const u32x4*)(prow + 3584 + lane * 8);
    x.gate = F.PG()[(size_t)r * 128 + (lane & 15)];
    return x;
}
__device__ __forceinline__ void prep_row(const Params& p, const Frame& F, int l, int r, int lane, const PrepRow& x) {
    const int b = r / TPB, t = r % TPB; const bool lat = t >= 256; const int n = lat ? t - 256 : 0;
    const int d0 = (lane & 15) * 8; const bool second = (lane & 8) != 0;
    const float* cs = F.ROPEG() + (size_t)n * 64 + (d0 & 63); const float* sn = cs + 2048 * 64;
    float csv[8], snv[8];
    { const f32x4 c0 = *(const f32x4*)cs, c1 = *(const f32x4*)(cs + 4), s0 = *(const f32x4*)sn, s1 = *(const f32x4*)(sn + 4);
#pragma unroll
      for (int j = 0; j < 4; ++j) { csv[j] = c0[j]; csv[4 + j] = c1[j]; snv[j] = s0[j]; snv[4 + j] = s1[j]; } }
#pragma unroll
    for (int ps = 0; ps < 2; ++ps) {
        float v[8]; unpack8(ps ? x.q1 : x.q0, v);
        float ss = 0.f;
#pragma unroll
        for (int j = 0; j < 8; ++j) ss += v[j] * v[j];
        ss = gsum16(ss); const float rs = 1.0f / sqrtf(ss * (1.0f / 128.0f) + EPSN);
        const float* gn = p.gqa_q_norm + l * 128 + d0;
        float y[8];
#pragma unroll
        for (int j = 0; j < 8; ++j) y[j] = v[j] * rs * gn[j];
#pragma unroll
        for (int j = 0; j < 8; ++j) { const float o = __shfl_xor(y[j], 8); if (lat) y[j] = second ? (y[j] * csv[j] + o * snv[j]) : (y[j] * csv[j] - o * snv[j]); }
#pragma unroll
        for (int j = 0; j < 8; ++j) y[j] *= QSCALE_G;
        *(u32x4*)(F.QG() + (size_t)r * 1024 + ps * 512 + lane * 8) = pack8(y);
    }
    {
        const bool isk = lane < 32;
        float v[8]; unpack8(x.kk, v);
        float ss = 0.f;
#pragma unroll
        for (int j = 0; j < 8; ++j) ss += v[j] * v[j];
        const float s16 = gsum16(ss), s32 = s16 + __shfl_xor(s16, 16);
        const float rs = 1.0f / sqrtf((isk ? s16 * (1.0f / 128.0f) : s32 * (1.0f / 256.0f)) + EPSN);
        const float* gn = isk ? p.gqa_k_norm + l * 128 + d0 : p.mla_kva_norm + l * 256 + (lane - 32) * 8;
        float y[8];
#pragma unroll
        for (int j = 0; j < 8; ++j) y[j] = v[j] * rs * gn[j];
#pragma unroll
        for (int j = 0; j < 8; ++j) { const float o = __shfl_xor(y[j], 8); if (lat && isk) y[j] = second ? (y[j] * csv[j] + o * snv[j]) : (y[j] * csv[j] - o * snv[j]); }
        bf16_t* dst = isk ? F.KG() + (size_t)r * 256 + lane * 8 : F.KVA() + (size_t)r * 256 + (lane - 32) * 8;
        *(u32x4*)dst = pack8(y);
    }
    {
        float v[8]; unpack8(x.qa, v);
        float ss = 0.f;
#pragma unroll
        for (int j = 0; j < 8; ++j) ss += v[j] * v[j];
        ss = wsum64(ss); const float rs = 1.0f / sqrtf(ss * (1.0f / 512.0f) + EPSN);
        const float* gn = p.mla_qa_norm + l * 512 + lane * 8;
        float y[8];
#pragma unroll
        for (int j = 0; j < 8; ++j) y[j] = v[j] * rs * gn[j];
        *(u32x4*)(F.QA() + (size_t)r * 512 + lane * 8) = pack8(y);
    }
    if (lane < 16) {
        const float g = x.gate + p.b_gates[l * 16 + lane];
        const int type = lane >> 2, head = lane & 3, dir = type >> 1;
        const float val = (type & 1) ? (fminf(g, 0.f) - log1pf(expf(-fabsf(g)))) : g;
        float* dstp = ((type & 1) ? F.GF() : F.GI()) + ((size_t)(dir * 8 + b) * 4 + head) * TPB + t;
        *dstp = val;
    }
}
__device__ __forceinline__ void ph_prep(const Params& p, const Frame& F0, int l) { const Frame F = fresh(F0);
    const int lane = F.lane, st = F.G * 8;
    int r = F.bid * 8 + F.wid;
    PrepRow a = prep_load(F, r < NTOK ? r : 0, lane), b2 = prep_load(F, (r + st < NTOK) ? r + st : 0, lane);
    for (; r < NTOK; r += 2 * st) {
        const int r2 = r + st, rn = r + 2 * st, rn2 = r + 3 * st; const bool has2 = r2 < NTOK;
        const PrepRow an = prep_load(F, rn < NTOK ? rn : 0, lane), bn = prep_load(F, rn2 < NTOK ? rn2 : 0, lane);
        prep_row(p, F, l, r, lane, a);
        if (has2) prep_row(p, F, l, r2, lane, b2);
        a = an; b2 = bn;
    }
}

struct MlaRow { u32x2 q[4], kn[4]; f32x4 kr; };
__device__ __forceinline__ MlaRow mla_load(const Frame& F, int r, int lane) {
    MlaRow x; const bool act = lane < 48, rp = lane >= 32 && lane < 48;
#pragma unroll
    for (int hh = 0; hh < 4; ++hh) {
        x.q[hh] = act ? *(const u32x2*)(F.MQ() + (size_t)r * 768 + hh * 192 + lane * 4) : (u32x2){0u, 0u};
        x.kn[hh] = (lane < 32) ? *(const u32x2*)(F.MKV() + (size_t)r * 1024 + hh * 256 + lane * 4) : (u32x2){0u, 0u}; }
    x.kr = rp ? *(const f32x4*)(F.PG() + (size_t)r * 128 + 16 + (lane - 32) * 4) : (f32x4){0.f, 0.f, 0.f, 0.f};
    return x;
}
__device__ __forceinline__ void mla_row(const Params& p, const Frame& F, int l, int r, int lane, const MlaRow& x) {
    const int t = r % TPB; const bool lat = t >= 256; const int n = lat ? t - 256 : 0;
    const bool act = lane < 48, rp = lane >= 32 && lane < 48;
    const float* cs = F.ROPEM() + (size_t)n * 32 + ((lane - 32) & 7) * 4; const float* sn = cs + 2048 * 32; const bool second = (lane & 8) != 0;
    float csv[4], snv[4];
    { const f32x4 c0 = rp ? *(const f32x4*)cs : (f32x4){1.f, 1.f, 1.f, 1.f}, s0 = rp ? *(const f32x4*)sn : (f32x4){0.f, 0.f, 0.f, 0.f};
#pragma unroll
      for (int j = 0; j < 4; ++j) { csv[j] = c0[j]; snv[j] = s0[j]; } }
#pragma unroll
    for (int pass = 0; pass < 8; ++pass) {
        const int hh = pass & 3; const bool isq = pass < 4;
        float v[4];
        if (isq) { const u32x2 w = x.q[hh]; v[0] = bflo(w.x); v[1] = bfhi(w.x); v[2] = bflo(w.y); v[3] = bfhi(w.y); }
        else { const u32x2 w = x.kn[hh]; v[0] = rp ? x.kr[0] : bflo(w.x); v[1] = rp ? x.kr[1] : bfhi(w.x); v[2] = rp ? x.kr[2] : bflo(w.y); v[3] = rp ? x.kr[3] : bfhi(w.y); }
        float ss = (v[0] * v[0] + v[1] * v[1]) + (v[2] * v[2] + v[3] * v[3]);
        ss = wsum64(ss); const float rs = 1.0f / sqrtf(ss * (1.0f / 192.0f) + EPSN);
        const float* gn = (isq ? p.mla_q_norm : p.mla_k_norm) + l * 192 + (act ? lane * 4 : 0);
        float y[4];
#pragma unroll
        for (int j = 0; j < 4; ++j) y[j] = v[j] * rs * gn[j];
#pragma unroll
        for (int j = 0; j < 4; ++j) { const float o = __shfl_xor(y[j], 8); if (lat && rp) y[j] = second ? (y[j] * csv[j] + o * snv[j]) : (y[j] * csv[j] - o * snv[j]); }
        if (isq) {
#pragma unroll
            for (int j = 0; j < 4; ++j) y[j] *= QSCALE_M; }
        if (act) { u32x2 w; w.x = cvt_pk_bf16(y[0], y[1]); w.y = cvt_pk_bf16(y[2], y[3]);
            *(u32x2*)((isq ? F.QM() : F.KM()) + (size_t)r * 768 + hh * 192 + lane * 4) = w; }
    }
}
__device__ __forceinline__ void ph_mla_prep(const Params& p, const Frame& F0, int l) { const Frame F = fresh(F0);
    const int lane = F.lane, st = F.G * 8;
    int r = F.bid * 8 + F.wid;
    MlaRow a = mla_load(F, r < NTOK ? r : 0, lane), b2 = mla_load(F, (r + st < NTOK) ? r + st : 0, lane);
    for (; r < NTOK; r += 2 * st) {
        const int r2 = r + st, rn = r + 2 * st, rn2 = r + 3 * st; const bool has2 = r2 < NTOK;
        const MlaRow an = mla_load(F, rn < NTOK ? rn : 0, lane), bn = mla_load(F, rn2 < NTOK ? rn2 : 0, lane);
        mla_row(p, F, l, r, lane, a);
        if (has2) mla_row(p, F, l, r2, lane, b2);
        a = an; b2 = bn;
    }
}

__device__ __forceinline__ void mp_block(const Params& p, const Frame& F, int l, int row0) {
    const int lane = F.lane; int r = row0 + F.wid;
    MlaRow a = mla_load(F, r, lane), b2 = mla_load(F, r + 8, lane);
    for (int k = 0; k < 4; ++k) { const bool more = k + 1 < 4;
        const MlaRow an = mla_load(F, more ? r + 16 : r, lane), bn = mla_load(F, more ? r + 24 : r, lane);
        mla_row(p, F, l, r, lane, a); mla_row(p, F, l, r + 8, lane, b2); a = an; b2 = bn; r += 16; }
}
struct MoRow { u32x4 a, b; u32x4 o; };
__device__ __forceinline__ MoRow mo_load(const Frame& F, int r, int lane) {
    MoRow x; x.a = *(const u32x4*)((const bf16_t*)F.HF() + (size_t)r * 512 + lane * 8); x.b = *(const u32x4*)((const bf16_t*)F.HB() + (size_t)r * 512 + lane * 8);
    x.o = *(const u32x4*)(F.P() + (size_t)r * NPW + 1536 + lane * 8); return x;
}
__device__ __forceinline__ void mo_row(const Params& p, const Frame& F, int l, int r, int lane, const MoRow& x) {
    float fa[8], fb[8]; unpack8(x.a, fa); unpack8(x.b, fb);
    float v[8];
#pragma unroll
    for (int j = 0; j < 8; ++j) v[j] = fa[j] + fb[j];
    float ss = 0.f;
#pragma unroll
    for (int j = 0; j < 8; ++j) ss += v[j] * v[j];
    ss = gsum16(ss); const float rs = 1.0f / sqrtf(ss * (1.0f / 128.0f) + EPSN);
    float o[8]; unpack8(x.o, o);
    const float* gn = p.ml_norm + l * 512 + lane * 8;
    float y[8];
#pragma unroll
    for (int j = 0; j < 8; ++j) y[j] = v[j] * rs * gn[j] / (1.0f + __expf(-o[j]));
    *(u32x4*)(F.MIX() + (size_t)r * 2048 + lane * 8) = pack8(y);
}
__device__ __forceinline__ void mo_block(const Params& p, const Frame& F, int l, int row0) {
    const int lane = F.lane; int r = row0 + F.wid;
    MoRow a = mo_load(F, r, lane), b2 = mo_load(F, r + 8, lane);
    for (int k = 0; k < 16; ++k) { const bool more = k + 1 < 16;
        const MoRow an = mo_load(F, more ? r + 16 : r, lane), bn = mo_load(F, more ? r + 24 : r, lane);
        mo_row(p, F, l, r, lane, a); mo_row(p, F, l, r + 8, lane, b2); a = an; b2 = bn; r += 16; }
}
__device__ __forceinline__ int queue_pop(const Frame& F, unsigned* ctr) {
    volatile LAS int* slot = (volatile LAS int*)(F.lds + LDS_MISC + 16);
    __syncthreads();
    if (F.tid == 0) *slot = (int)__hip_atomic_fetch_add(ctr, 1u, __ATOMIC_RELAXED, __HIP_MEMORY_SCOPE_AGENT);
    __syncthreads();
    return __builtin_amdgcn_readfirstlane(*slot);
}
__device__ __forceinline__ void ph_mixer(const Params& p, const Frame& F0, int l, int rep, int skip) { const Frame F = fresh(F0);
    const bool need_ctx = (l + 1 < NLAYER);
    if (!(DIS & (1 << 16)) && !((skip & 1) && rep) && F.bid < 64) {
        const int sid = F.bid, dir = sid & 1, h = (sid >> 1) & 3, b = sid >> 3;
        const size_t go = ((size_t)(dir * 8 + b) * 4 + h) * TPB;
        ml::mlstm_seq(F.lds, F.P(), F.GI() + go, F.GF() + go, (bf16_t*)(dir ? F.HB() : F.HF()), b, h, dir, need_ctx);
        if (MO_IN_MIXER) {
            asm volatile("s_waitcnt vmcnt(0)" ::: "memory"); __syncthreads();
            if (F.tid == 0) { __builtin_amdgcn_fence(__ATOMIC_RELEASE, "agent");
                __hip_atomic_fetch_add(F.ctl() + CTL_Q / 4 + (32 + l * 8 + b) * 64, 1u, __ATOMIC_RELAXED, __HIP_MEMORY_SCOPE_AGENT); }
        }
    }
    bool umaxM, umaxG;
    { float a = 0.f, b2 = 0.f, c = 0.f, d = 0.f; const int lane = F.lane;
      for (int i = lane; i < 192; i += 64) { a = fmaxf(a, fabsf(p.mla_q_norm[l * 192 + i])); b2 = fmaxf(b2, fabsf(p.mla_k_norm[l * 192 + i])); }
      for (int i = lane; i < 128; i += 64) { c = fmaxf(c, fabsf(p.gqa_q_norm[l * 128 + i])); d = fmaxf(d, fabsf(p.gqa_k_norm[l * 128 + i])); }
#pragma unroll
      for (int o = 32; o > 0; o >>= 1) { a = fmaxf(a, __shfl_xor(a, o)); b2 = fmaxf(b2, __shfl_xor(b2, o)); c = fmaxf(c, __shfl_xor(c, o)); d = fmaxf(d, __shfl_xor(d, o)); }
      const float bM = 13.8564065f * 1.44269504f * a * b2, bG = 11.3137085f * 1.44269504f * c * d;
      umaxM = __builtin_amdgcn_readfirstlane(!(bM < 96.f)) != 0; umaxG = __builtin_amdgcn_readfirstlane(!(bG < 96.f)) != 0; }
    if (!(DIS & (1 << 17)) && !((skip & 2) && rep)) {
        unsigned* ctr = F.ctl() + CTL_Q / 4 + (rep * 4 + l * 2 + 0) * 64;
        const int nA = 256 + (need_ctx ? 32 : 0), nP = (MP_IN_MIXER && !rep) ? 288 : 0;
        if (nP) {
            unsigned* ctrP = F.ctl() + CTL_Q / 4 + (16 + l) * 64;
            for (;;) {
                const int ip = queue_pop(F, ctrP); if (ip >= nP) break;
                mp_block(p, F, l, ip * 64);
                asm volatile("s_waitcnt vmcnt(0)" ::: "memory"); __syncthreads();
                if (F.tid == 0) { __builtin_amdgcn_fence(__ATOMIC_RELEASE, "agent");
                    __hip_atomic_fetch_add(F.ctl() + CTL_Q / 4 + (64 + l) * 64, 1u, __ATOMIC_RELAXED, __HIP_MEMORY_SCOPE_AGENT); }
            }
            if (F.tid == 0) { unsigned* fl = F.ctl() + CTL_Q / 4 + (64 + l) * 64;
                while (__hip_atomic_load(fl, __ATOMIC_RELAXED, __HIP_MEMORY_SCOPE_AGENT) < 288u) __builtin_amdgcn_s_sleep(2);
                __builtin_amdgcn_fence(__ATOMIC_ACQUIRE, "agent"); asm volatile("s_waitcnt vmcnt(0)" ::: "memory"); }
            __syncthreads();
        }
        for (;;) {
            const int it = queue_pop(F, ctr); if (it >= nA) break;
            int b, h, q0, seq;
            if (it < 256) { b = it >> 5; h = (it >> 3) & 3; q0 = 256 + (it & 7) * 256; seq = TPB; } else { const int j = it - 256; b = j >> 2; h = j & 3; q0 = 0; seq = 256; }
            const size_t rq = (size_t)b * TPB + q0, rk = (size_t)b * TPB;
            att::ATTN_BODY<192, 768, 768, 1024, 2048>(F.QM() + rq * 768 + h * 192, F.KM() + rk * 768 + h * 192, F.MKV() + rk * 1024 + h * 256 + 128, F.MIX() + rq * 2048 + 1536 + h * 128, seq, F.lds, umaxM);
        }
    }
    if (!(DIS & (1 << 18)) && !((skip & 4) && rep)) for (int rep2 = 0; rep2 < 1 + ((REP >> 20) & 1); ++rep2) {
        unsigned* ctr = F.ctl() + CTL_Q / 4 + (rep2 * 8 + rep * 4 + l * 2 + 1) * 64;
        constexpr int NFULL = 512 - GQA_SPLIT, NLAT = NFULL + 2 * GQA_SPLIT;
        const int nB = NLAT + (need_ctx ? 64 : 0), nMO = (MO_IN_MIXER && !rep) ? 72 : 0;
        const int nCV = (F.G == 256 && !rep) ? 2 * (l == 0 ? CVT_MQ0 : CVT_MQ1) : 0, cvbase = l == 0 ? CVT_C0 - CVT_MQ0 : CVT_D0 - CVT_MQ1;
        for (;;) {
            const int it = queue_pop(F, ctr); if (it >= nB + nMO + nCV) break;
            if (it >= nB + nMO) { const int j = it - nB - nMO; cvt_item(p, F, cvbase + (j >> 1), j & 1); continue; }
            if (it >= nB) {
                const int i = it - nB, bb = i / 9, ti = i % 9;
                if (!need_ctx && ti == 0) continue;
                if (F.tid == 0) { unsigned* fl = F.ctl() + CTL_Q / 4 + (32 + l * 8 + bb) * 64;
                    while (__hip_atomic_load(fl, __ATOMIC_RELAXED, __HIP_MEMORY_SCOPE_AGENT) < 8u) __builtin_amdgcn_s_sleep(2);
                    __builtin_amdgcn_fence(__ATOMIC_ACQUIRE, "agent"); asm volatile("s_waitcnt vmcnt(0)" ::: "memory"); }
                __syncthreads();
                mo_block(p, F, l, i * 256);
                continue;
            }
            int b, hq, q0, seq, nact = 8;
            if (it < NLAT) { int f = it, hf = 0; if (it >= NFULL) { f = NFULL + ((it - NFULL) >> 1); hf = (it - NFULL) & 1; nact = 4; }
                b = f >> 6; hq = (f >> 3) & 7; q0 = 256 + (f & 7) * 256 + hf * 128; seq = TPB; }
            else { const int j = it - NLAT; b = j >> 3; hq = j & 7; q0 = 0; seq = 256; }
            const size_t rq = (size_t)b * TPB + q0, rk = (size_t)b * TPB; const int kv = hq >> 2;
            att::ATTN_BODY<128, 1024, 256, NPW, 2048>(F.QG() + rq * 1024 + hq * 128, F.KG() + rk * 256 + kv * 128, F.P() + rk * NPW + 3328 + kv * 128, F.MIX() + rq * 2048 + 512 + hq * 128, seq, F.lds, umaxG, ((rep || rep2) && PROBE_NACT >= 0) ? PROBE_NACT : nact);
        }
    }
}

__device__ __forceinline__ void ph_mlstm_out(const Params& p, const Frame& F0, int l) { const Frame F = fresh(F0);
    const int lane = F.lane, st = F.G * 8; const bool need_ctx = (l + 1 < NLAYER);
    int r = F.bid * 8 + F.wid;
    MoRow a = mo_load(F, r < NTOK ? r : 0, lane), b2 = mo_load(F, (r + st < NTOK) ? r + st : 0, lane);
    for (; r < NTOK; r += 2 * st) {
        const int r2 = r + st, rn = r + 2 * st, rn2 = r + 3 * st; const bool has2 = r2 < NTOK;
        const MoRow an = mo_load(F, rn < NTOK ? rn : 0, lane), bn = mo_load(F, rn2 < NTOK ? rn2 : 0, lane);
        const bool ok1 = need_ctx || (r % TPB) >= 256, ok2 = has2 && (need_ctx || (r2 % TPB) >= 256);
        if (ok1) mo_row(p, F, l, r, lane, a);
        if (ok2) mo_row(p, F, l, r2, lane, b2);
        a = an; b2 = bn;
    }
}

__device__ __forceinline__ float router_reduce16(float (&lg)[16], int lane) {
    const bool b5 = lane & 32, b4 = lane & 16, b3 = lane & 8, b2 = lane & 4;
    float k8[8], k4[4], k2[2];
#pragma unroll
    for (int j = 0; j < 8; ++j) { const float snd = b5 ? lg[j] : lg[8 + j]; const float rcv = __shfl_xor(snd, 32); k8[j] = (b5 ? lg[8 + j] : lg[j]) + rcv; }
#pragma unroll
    for (int j = 0; j < 4; ++j) { const float snd = b4 ? k8[j] : k8[4 + j]; const float rcv = __shfl_xor(snd, 16); k4[j] = (b4 ? k8[4 + j] : k8[j]) + rcv; }
#pragma unroll
    for (int j = 0; j < 2; ++j) { const float snd = b3 ? k4[j] : k4[2 + j]; const float rcv = __shfl_xor(snd, 8); k2[j] = (b3 ? k4[2 + j] : k4[j]) + rcv; }
    float v; { const float snd = b2 ? k2[0] : k2[1]; const float rcv = __shfl_xor(snd, 4); v = (b2 ? k2[1] : k2[0]) + rcv; }
    v += __shfl_xor(v, 2); v += __shfl_xor(v, 1);
    return v;
}
__device__ __forceinline__ void ph_router_valu(const Params& p, const Frame& F0, int l) { const Frame F = fresh(F0);
    const int lane = F.lane, tid = F.tid; const bool need_ctx = (l + 1 < NLAYER);
    LAS float* WR = (LAS float*)F.lds;
    for (int rp1 = 0; rp1 < 1 + RPROBE1; ++rp1) { __syncthreads();
    { const f32x4* w4 = (const f32x4*)(p.w_router + (size_t)l * 2048 * 16);
      f32x4 wv[16];
#pragma unroll
      for (int k = 0; k < 16; ++k) wv[k] = w4[tid + k * 512];
#pragma unroll
      for (int k = 0; k < 16; ++k) { const int i4 = tid + k * 512, d = i4 >> 2, e0 = (i4 & 3) * 4;
#pragma unroll
          for (int j = 0; j < 4; ++j) WR[(e0 + j) * 2052 + d] = wv[k][j]; } }
    __syncthreads(); }
    const int st = F.G * 8; const float* nwl = p.norm2 + (size_t)l * DM + lane * 4;
    const LAS float* wrl = WR + lane * 4;
    for (int rp2 = 0; rp2 < 1 + RPROBE2; ++rp2)
    for (int r0 = F.bid * 8 + F.wid; r0 < NTOK; r0 += 2 * st) {
        const int ra = r0, rb = (r0 + st < NTOK) ? r0 + st : r0;
        const int ba = ra / TPB, ta = ra % TPB, bb = rb / TPB, tb = rb % TPB;
        const bool va = need_ctx || ta >= 256, vb = (r0 + st < NTOK) && (need_ctx || tb >= 256);
        const float* xa = F.X() + (size_t)ra * DM + lane * 4; const float* xb = F.X() + (size_t)rb * DM + lane * 4;
        const float* ma = F.MOD() + ((size_t)l * 9 + (ta < 256 ? 8 : ba)) * 12288 + 3 * 2048 + lane * 4;
        const float* mb = F.MOD() + ((size_t)l * 9 + (tb < 256 ? 8 : bb)) * 12288 + 3 * 2048 + lane * 4;
        bf16_t* ha = F.H() + (size_t)ra * DM + lane * 4; bf16_t* hb = F.H() + (size_t)rb * DM + lane * 4;
        const LAS float* wr2 = wrl; asm volatile("" : "+v"(wr2));
        f32x4 xva[8], xvb[8];
#pragma unroll
        for (int i = 0; i < 8; ++i) { xva[i] = *(const f32x4*)(xa + i * 256); xvb[i] = *(const f32x4*)(xb + i * 256); }
        float ssa = 0.f, ssb = 0.f;
#pragma unroll
        for (int i = 0; i < 8; ++i) { ssa += (xva[i][0] * xva[i][0] + xva[i][1] * xva[i][1]) + (xva[i][2] * xva[i][2] + xva[i][3] * xva[i][3]);
                                      ssb += (xvb[i][0] * xvb[i][0] + xvb[i][1] * xvb[i][1]) + (xvb[i][2] * xvb[i][2] + xvb[i][3] * xvb[i][3]); }
        ssa = wsum64(ssa); ssb = wsum64(ssb);
        const float rsa = 1.0f / sqrtf(ssa * (1.0f / DM) + EPSN), rsb = 1.0f / sqrtf(ssb * (1.0f / DM) + EPSN);
        float lga[16], lgb[16];
#pragma unroll
        for (int e = 0; e < 16; ++e) { lga[e] = 0.f; lgb[e] = 0.f; }
#pragma unroll
        for (int i = 0; i < 8; ++i) {
            const f32x4 g = *(const f32x4*)(nwl + i * 256);
            xva[i] = xva[i] * rsa * g * (*(const f32x4*)(ma + 2048 + i * 256) + 1.0f) + *(const f32x4*)(ma + i * 256);
            xvb[i] = xvb[i] * rsb * g * (*(const f32x4*)(mb + 2048 + i * 256) + 1.0f) + *(const f32x4*)(mb + i * 256);
            if (va) { u32x2 w; w.x = cvt_pk_bf16(xva[i][0], xva[i][1]); w.y = cvt_pk_bf16(xva[i][2], xva[i][3]); *(u32x2*)(ha + i * 256) = w; }
            if (vb) { u32x2 w; w.x = cvt_pk_bf16(xvb[i][0], xvb[i][1]); w.y = cvt_pk_bf16(xvb[i][2], xvb[i][3]); *(u32x2*)(hb + i * 256) = w; }
        }
        if (!(RPROBE_SKIP && rp2 > 0)) {
            f32x4 wcur[4], wnxt[4];
#pragma unroll
            for (int e = 0; e < 4; ++e) wcur[e] = *(const LAS f32x4*)(wr2 + e * 2052);
#pragma unroll
            for (int g = 0; g < 32; ++g) {
                const int i = g >> 2, eg = g & 3;
                if (g + 1 < 32) { const int i2 = (g + 1) >> 2, eg2 = (g + 1) & 3;
#pragma unroll
                    for (int e = 0; e < 4; ++e) wnxt[e] = *(const LAS f32x4*)(wr2 + (eg2 * 4 + e) * 2052 + i2 * 256); }
                const f32x4 hva = xva[i], hvb = xvb[i];
#pragma unroll
                for (int e = 0; e < 4; ++e) {
                    float a = lga[eg * 4 + e], bq = lgb[eg * 4 + e];
                    a = fmaf(hva[0], wcur[e][0], a); a = fmaf(hva[1], wcur[e][1], a); a = fmaf(hva[2], wcur[e][2], a); a = fmaf(hva[3], wcur[e][3], a);
                    bq = fmaf(hvb[0], wcur[e][0], bq); bq = fmaf(hvb[1], wcur[e][1], bq); bq = fmaf(hvb[2], wcur[e][2], bq); bq = fmaf(hvb[3], wcur[e][3], bq);
                    lga[eg * 4 + e] = a; lgb[eg * 4 + e] = bq; }
#pragma unroll
                for (int e = 0; e < 4; ++e) asm volatile("" : "+v"(lga[eg * 4 + e]), "+v"(lgb[eg * 4 + e]));
#pragma unroll
                for (int e = 0; e < 4; ++e) wcur[e] = wnxt[e];
                __builtin_amdgcn_sched_barrier(0);
            }
        }
        if (!(RPROBE_SKIP && rp2 > 0))
#pragma unroll
        for (int q = 0; q < 2; ++q) {
            const float v = q ? router_reduce16(lgb, lane) : router_reduce16(lga, lane);
            float mx = v;
#pragma unroll
            for (int o = 4; o < 64; o <<= 1) mx = fmaxf(mx, __shfl_xor(mx, o));
            const float ex = expf(v - mx); float sum = ex;
#pragma unroll
            for (int o = 4; o < 64; o <<= 1) sum += __shfl_xor(sum, o);
            if ((q ? vb : va) && (lane & 3) == 0) F.AFF()[((size_t)(q ? bb : ba) * 16 + (lane >> 2)) * TPB + (q ? tb : ta)] = ex / sum;
        }
    }
    __syncthreads();
}

__device__ __forceinline__ void ph_router(const Params& p, const Frame& F0, int l) { const Frame F = fresh(F0);
    const int lane = F.lane, tid = F.tid, wid = F.wid, t16 = lane & 15, kq = lane >> 4; const bool need_ctx = (l + 1 < NLAYER);
    LAS float* WRm = (LAS float*)F.lds; LAS float* PART = WRm + 32768; LAS float* SSP = PART + 2 * 2048; LAS float* CC = SSP + 2 * 128;
    const float* wr = p.w_router + (size_t)l * 2048 * 16;
    { const int e = tid & 15, part = tid >> 4; float ac[9];
#pragma unroll
      for (int m = 0; m < 9; ++m) ac[m] = 0.f;
      const float* shb = F.MOD() + (size_t)l * 9 * 12288 + 3 * 2048;
#pragma unroll 8
      for (int dd = 0; dd < 64; ++dd) { const int d = part * 64 + dd; const float wv = wr[d * 16 + e];
#pragma unroll
          for (int m = 0; m < 9; ++m) ac[m] += shb[(size_t)m * 12288 + d] * wv; }
#pragma unroll
      for (int m = 0; m < 9; ++m) WRm[(m * 32 + part) * 16 + e] = ac[m];
      __syncthreads();
      if (tid < 144) { const int m = tid >> 4, e2 = tid & 15; float sum = 0.f;
#pragma unroll
          for (int q = 0; q < 32; ++q) sum += WRm[(m * 32 + q) * 16 + e2];
          CC[tid] = sum; }
      __syncthreads(); }
    { const f32x4* w4 = (const f32x4*)wr;
      f32x4 wv[16];
#pragma unroll
      for (int k = 0; k < 16; ++k) wv[k] = w4[tid + k * 512];
#pragma unroll
      for (int k = 0; k < 16; ++k) { const int i4 = tid + k * 512, d = i4 >> 2, e0 = (i4 & 3) * 4;
          const int base = (((d >> 8) * 16 + ((d >> 4) & 15)) * 64 + ((d >> 2) & 3) * 16) * 4 + (d & 3);
#pragma unroll
          for (int j = 0; j < 4; ++j) WRm[base + (e0 + j) * 4] = wv[k][j]; } }
    __syncthreads();
    const float* nwl = p.norm2 + (size_t)l * DM + 256 * wid + 4 * kq;
    const LAS float* bl = WRm + (wid * 16) * 256 + lane * 4;
    const int ngl = need_ctx ? NTOK / 16 : (NTOK / 16) - NB * 16;
    const int k0 = (int)(((long)F.bid * ngl) / F.G), k1 = (int)(((long)(F.bid + 1) * ngl) / F.G);
#define RT_GRP(k) (need_ctx ? (k) : ((k) >> 7) * 144 + 16 + ((k) & 127))
    int kk = k0; int g = (kk < k1) ? RT_GRP(kk) : NTOK / 16;
    f32x4 xq[16], xn[16];
    if (g < NTOK / 16) { const float* xrow = F.X() + (size_t)(g * 16 + t16) * DM + 256 * wid + 4 * kq;
#pragma unroll
        for (int j = 0; j < 16; ++j) xq[j] = *(const f32x4*)(xrow + 16 * j); }
    int buf = 0;
    while (g < NTOK / 16) {
        ++kk; const int gn = (kk < k1) ? RT_GRP(kk) : NTOK / 16;
        if (gn < NTOK / 16) { const float* xrow = F.X() + (size_t)(gn * 16 + t16) * DM + 256 * wid + 4 * kq;
#pragma unroll
            for (int j = 0; j < 16; ++j) xn[j] = *(const f32x4*)(xrow + 16 * j); }
        const int row0 = g * 16, b = row0 / TPB, t0 = row0 % TPB; const int mr = (t0 < 256) ? 8 : b;
        const float* md = F.MOD() + ((size_t)l * 9 + mr) * 12288 + 256 * wid + 4 * kq;
        LAS float* PB = PART + buf * 2048; LAS float* SB = SSP + buf * 128;
        f32x4 acc = (f32x4){0.f, 0.f, 0.f, 0.f}; float ss = 0.f;
#pragma unroll
        for (int j = 0; j < 16; ++j) {
            const f32x4 g4 = *(const f32x4*)(nwl + 16 * j), sc4 = *(const f32x4*)(md + 4 * 2048 + 16 * j);
            const f32x4 bq = *(const LAS f32x4*)(bl + j * 256);
            ss += (xq[j][0] * xq[j][0] + xq[j][1] * xq[j][1]) + (xq[j][2] * xq[j][2] + xq[j][3] * xq[j][3]);
            xq[j] = xq[j] * (g4 * (sc4 + 1.0f));
#pragma unroll
            for (int c = 0; c < 4; ++c) acc = __builtin_amdgcn_mfma_f32_16x16x4f32(xq[j][c], bq[c], acc, 0, 0, 0);
        }
        ss += __shfl_xor(ss, 16); ss += __shfl_xor(ss, 32);
#pragma unroll
        for (int r = 0; r < 4; ++r) PB[(wid * 16 + 4 * kq + r) * 16 + t16] = acc[r];
        if (kq == 0) SB[wid * 16 + t16] = ss;
        __syncthreads();
        float sst = 0.f;
#pragma unroll
        for (int w = 0; w < 8; ++w) sst += SB[w * 16 + t16];
        const float rstd = 1.0f / sqrtf(sst * (1.0f / DM) + EPSN);
        {
            const int tok = 2 * wid + (kq & 1); float lgv = 0.f, s2 = 0.f;
#pragma unroll
            for (int w = 0; w < 8; ++w) { lgv += PB[(w * 16 + tok) * 16 + t16]; s2 += SB[w * 16 + tok]; }
            lgv = lgv * (1.0f / sqrtf(s2 * (1.0f / DM) + EPSN)) + CC[mr * 16 + t16];
            float mx = lgv;
#pragma unroll
            for (int o = 1; o < 16; o <<= 1) mx = fmaxf(mx, __shfl_xor(mx, o));
            const float ex = expf(lgv - mx); float sum = ex;
#pragma unroll
            for (int o = 1; o < 16; o <<= 1) sum += __shfl_xor(sum, o);
            if (lane < 32) F.AFF()[((size_t)b * 16 + t16) * TPB + t0 + tok] = ex / sum;
        }
        bf16_t* hrow = F.H() + (size_t)(row0 + t16) * DM + 256 * wid + 4 * kq;
#pragma unroll
        for (int j = 0; j < 16; ++j) { const f32x4 sh4 = *(const f32x4*)(md + 3 * 2048 + 16 * j); const f32x4 hv = xq[j] * rstd + sh4;
            u32x2 w; w.x = cvt_pk_bf16(hv[0], hv[1]); w.y = cvt_pk_bf16(hv[2], hv[3]); *(u32x2*)(hrow + 16 * j) = w; }
#pragma unroll
        for (int j = 0; j < 16; ++j) xq[j] = xn[j];
        g = gn; buf ^= 1;
    }
#undef RT_GRP
    __syncthreads();
}

__device__ __forceinline__ int block_scan(int v, LAS int* tmp, int tid, int lane, int wid, int* tot) {
    int inc = v;
#pragma unroll
    for (int o = 1; o < 64; o <<= 1) { const int t = __shfl_up(inc, o); if (lane >= o) inc += t; }
    __syncthreads();
    if (lane == 63) tmp[wid] = inc;
    __syncthreads();
    int base = 0, total = 0;
#pragma unroll
    for (int w = 0; w < 8; ++w) { const int c = tmp[w]; if (w < wid) base += c; total += c; }
    *tot = total;
    return base + inc - v;
}
__device__ __forceinline__ void ph_topk(const Params& p, const Frame& F0, int l) { const Frame F = fresh(F0);
    const int tid = F.tid, lane = F.lane, wid = F.wid; const bool need_ctx = (l + 1 < NLAYER);
    const int RPB = need_ctx ? 288 : 256, RPE = 8 * RPB, nprob = need_ctx ? 256 : 128;
    LAS unsigned* keys = (LAS unsigned*)F.lds; LAS unsigned* hist = keys + 2048; LAS int* tmp = (LAS int*)(hist + 8 * 256); LAS unsigned* sel = (LAS unsigned*)(tmp + 16);
    for (int pr = F.bid; pr < nprob; pr += F.G) {
        const int seg = pr >> 7, be = pr & 127, b = be >> 4, e = be & 15;
        const int n = seg ? 256 : 2048, off = seg ? 0 : 256, cap = seg ? 32 : 256;
        const float* a = F.AFF() + ((size_t)b * 16 + e) * TPB + off;
        __syncthreads();
        for (int i = tid; i < n; i += 512) keys[i] = __float_as_uint(a[i]);
        unsigned prefix = 0u, mask = 0u; int remaining = cap;
        for (int pass = 0; pass < 4; ++pass) {
            const int shift = 24 - 8 * pass;
            for (int i = tid; i < 8 * 256; i += 512) hist[i] = 0u;
            __syncthreads();
            for (int i = tid; i < n; i += 512) { const unsigned k = keys[i]; if ((k & mask) == prefix) __hip_atomic_fetch_add(&hist[wid * 256 + ((k >> shift) & 255u)], 1u, __ATOMIC_RELAXED, __HIP_MEMORY_SCOPE_WORKGROUP); }
            __syncthreads();
            int hv = 0;
            if (tid < 256) { const int bin = 255 - tid;
#pragma unroll
                for (int w = 0; w < 8; ++w) hv += (int)hist[w * 256 + bin]; }
            int tot; const int gt = block_scan(hv, tmp, tid, lane, wid, &tot);
            if (tid < 256 && hv > 0 && gt < remaining && remaining <= gt + hv) { sel[0] = (unsigned)(255 - tid); sel[1] = (unsigned)(remaining - gt); }
            __syncthreads();
            prefix |= sel[0] << shift; mask |= 255u << shift; remaining = (int)sel[1];
            __syncthreads();
        }
        const int per = n / 512 > 0 ? n / 512 : 1;
        const int i0 = tid * per; const bool actv = i0 < n;
        unsigned kk[4]; int eqc = 0;
#pragma unroll
        for (int j = 0; j < 4; ++j) { kk[j] = (actv && j < per) ? keys[i0 + j] : 0u; if (actv && j < per && kk[j] == prefix) ++eqc; }
        int tot; const int eqbase = block_scan(eqc, tmp, tid, lane, wid, &tot);
        int selc = 0, er = eqbase; bool sl[4];
#pragma unroll
        for (int j = 0; j < 4; ++j) { sl[j] = false; if (actv && j < per) { if (kk[j] > prefix) sl[j] = true; else if (kk[j] == prefix) { sl[j] = er < remaining; ++er; } } if (sl[j]) ++selc; }
        int rank = block_scan(selc, tmp, tid, lane, wid, &tot);
#pragma unroll
        for (int j = 0; j < 4; ++j) if (actv && j < per) {
            const int tok = b * TPB + off + i0 + j; int slot = -1;
            if (sl[j]) { slot = e * RPE + b * RPB + (seg ? 256 : 0) + rank; ++rank; F.PTOK()[slot] = tok; F.PGV()[slot] = __uint_as_float(kk[j]); }
            F.TOKSLOT()[(size_t)tok * 16 + e] = slot; }
    }
    if (!need_ctx && F.G == 256 && F.bid >= 128 && CVT_TKQ > 0) { const int w = F.bid - 128;
        if (w < 2 * CVT_TKQ) { __syncthreads(); cvt_item(p, F, CVT_D0 - CVT_MQ1 - CVT_TKQ + (w >> 1), w & 1); } }
    __syncthreads();
}

__device__ __forceinline__ void ph_gather(const Frame& F0, int l) { const Frame F = fresh(F0);
    const int lane = F.lane; const int npair = (l + 1 < NLAYER) ? 36864 : 32768;
    for (int pr = F.bid * 8 + F.wid; pr < npair; pr += F.G * 8) {
        const int tok = F.PTOK()[pr];
        const u32x4* src = (const u32x4*)(F.H() + (size_t)tok * DM); u32x4* dst = (u32x4*)(F.XG() + (size_t)pr * DM);
        const u32x4 a = src[lane], b2 = src[64 + lane], c = src[128 + lane], d = src[192 + lane];
        dst[lane] = a; dst[64 + lane] = b2; dst[128 + lane] = c; dst[192 + lane] = d;
    }
}
#ifndef DIS
#define DIS 0
#endif
#ifndef MK_PER_PHASE
#define MK_PER_PHASE 0
#endif
constexpr int NPH_LAYER = 13, NPHASE = 2 + NLAYER * NPH_LAYER;

__global__ void __launch_bounds__(512, 2) mk_fwd(Params p) {
    extern __shared__ __attribute__((aligned(16))) unsigned char lds_raw[];
    Frame F;
    F.lds = (LAS unsigned char*)lds_raw; F.ws = (__attribute__((address_space(1))) unsigned char*)p.ws;
    F.tid = threadIdx.x; F.lane = F.tid & 63; F.wid = __builtin_amdgcn_readfirstlane(F.tid >> 6); F.bid = blockIdx.x; F.G = gridDim.x;
    F.vcu = (F.G % 8 == 0) ? (F.bid % 8) * (F.G / 8) + F.bid / 8 : F.bid;

    if (F.tid < 16) ((LAS unsigned*)(F.lds + LDS_MISC))[F.tid] = 0u;
    __syncthreads();
#if MK_PER_PHASE
#define GRID_BAR() do { } while (0)
#else
    XcdBarrier bar = xcd_barrier_post(F.ctl(), (volatile LAS unsigned*)(F.lds + LDS_MISC));
#define GRID_BAR() xcd_barrier(bar)
#endif
    const int lo = p.ph_lo, hi = p.ph_hi;
#define IN(k) (lo <= (k) && (k) < hi)
#define SEAM(k) do { if (IN(k) && IN((k) + 1)) GRID_BAR(); } while (0)

    if (!(DIS & 1) && IN(0)) { ph_prologue(p, F); if (REP & 1) { __syncthreads(); ph_prologue(p, F); } }
    SEAM(0);
    for (int l = 0; l < NLAYER; ++l) {
        const int pb = 1 + l * NPH_LAYER;
        const bool need_ctx = (l + 1 < NLAYER);
        if (!(DIS & (1 << 1)) && IN(pb + 0)) { ph_norm1(p, F, l, l == 0 ? 0 : 1); if ((REP & 2) && l == 0) { __syncthreads(); ph_norm1(p, F, l, 0); } }
        SEAM(pb + 0);
        if (!(DIS & (1 << 2)) && IN(pb + 1)) for (int rep = 0; rep < (((REP >> 2) & 1) + 1); ++rep) { if (rep) __syncthreads();
            pg8::Gemm g{F.H(), F.WIN() + (size_t)l * NPW * 2048, NTOK, NPW, 2048};
            EpiInProj E{F.P(), F.PG()};
            const bool split = (F.G == 256) && (SIDE_MASK & (need_ctx ? 1 : 8)); const int xcd = F.bid & 7, lid = F.bid >> 3;
            if (need_ctx) {
                const int ngx = 27;
                if (!split || lid < ngx) { TileOrder S; if (!split) S.init(72, 18, F.G, F.vcu, 0); else S.init(72, 18, 8 * ngx, xcd * ngx + lid, 0);
                    pg8::gemm_phase<EpiInProj, TileOrder, true, true>(F.lds, g, S, E); }
                else ph_convert_side(p, F, ngx, CVT_A0, CVT_A1);
            } else {
                const int ngx = 31;
                if (!split || lid < ngx) { InProjLastOrder S; if (!split) S.init(F.G, F.vcu); else S.init(8 * ngx, xcd * ngx + lid);
                    pg8::gemm_phase<EpiInProj, InProjLastOrder, true, true>(F.lds, g, S, E); }
                else ph_convert_side(p, F, ngx, CVT_D0, CVT_D1);
            }
        }
        SEAM(pb + 1);
        if (!(DIS & (1 << 3)) && IN(pb + 2)) for (int rep = 0; rep < (((REP >> 3) & 1) + 1); ++rep) { if (rep) __syncthreads(); ph_prep(p, F, l); }
        SEAM(pb + 2);
        if (!(DIS & (1 << 4)) && IN(pb + 3)) for (int rep = 0; rep < (((REP >> 4) & 1) + 1); ++rep) { if (rep) __syncthreads();
            { pg8::Gemm g{F.QA(), F.WUQ() + (size_t)l * 768 * 512, NTOK, 768, 512}; TileOrder S; S.init(72, 3, F.G, F.vcu, 0);
              EpiBf16Store E{F.MQ(), 768};
              pg8::gemm_phase<EpiBf16Store, TileOrder, true, true>(F.lds, g, S, E); }
            __syncthreads();
            { pg8::Gemm g{F.KVA(), F.WUKV() + (size_t)l * 1024 * 256, NTOK, 1024, 256}; TileOrder S; S.init(72, 4, F.G, (F.vcu + 216) % F.G, 0);
              EpiBf16Store E{F.MKV(), 1024};
              pg8::gemm_phase<EpiBf16Store, TileOrder, true, true>(F.lds, g, S, E); }
        }
        SEAM(pb + 3);
        if (!MP_IN_MIXER) { if (!(DIS & (1 << 5)) && IN(pb + 4)) for (int rep = 0; rep < (((REP >> 5) & 1) + 1); ++rep) { if (rep) __syncthreads(); ph_mla_prep(p, F, l); }
            SEAM(pb + 4); }
        if (!(DIS & (1 << 6)) && IN(pb + 5)) { ph_mixer(p, F, l, 0, REP >> 16); if (REP & 0x40) { __syncthreads(); ph_mixer(p, F, l, 1, REP >> 16); } }
        SEAM(pb + 5);
        if (!MO_IN_MIXER) { if (!(DIS & (1 << 7)) && IN(pb + 6)) for (int rep = 0; rep < (((REP >> 7) & 1) + 1); ++rep) { if (rep) __syncthreads(); ph_mlstm_out(p, F, l); }
            SEAM(pb + 6); }
        if (!(DIS & (1 << 8)) && IN(pb + 7)) {
            pg8::Gemm g{F.MIX(), F.WOUT() + (size_t)l * 2048 * 2048, NTOK, 2048, 2048};
            EpiOutProj E{F.X(), F.MOD() + (size_t)l * 9 * 12288 + 2 * 2048, need_ctx ? p.x : nullptr, p.ctx};
            const bool split = (F.G == 256) && need_ctx && (SIDE_MASK & 2); const int xcd = F.bid & 7, lid = F.bid >> 3, ngx = 24;
            if (!split || lid < ngx) { TileOrder S; if (!split) S.init(need_ctx ? 72 : 64, 8, F.G, F.vcu, need_ctx ? 0 : 1); else S.init(72, 8, 8 * ngx, xcd * ngx + lid, 0);
                pg8::gemm_phase<EpiOutProj, TileOrder, true, true>(F.lds, g, S, E); }
            else ph_convert_side(p, F, ngx, CVT_B0, CVT_B1);
        }
        SEAM(pb + 7);
        if (!(DIS & (1 << 9)) && IN(pb + 8)) for (int rep = 0; rep < (((REP >> 9) & 1) + 1); ++rep) { if (rep) __syncthreads(); if (ROUTER_MFMA) ph_router(p, F, l); else ph_router_valu(p, F, l); }
        SEAM(pb + 8);
        if (!(DIS & (1 << 10)) && IN(pb + 9)) for (int rep = 0; rep < (((REP >> 10) & 1) + 1); ++rep) { if (rep) __syncthreads(); ph_topk(p, F, l); }
        SEAM(pb + 9);
        if (!(DIS & (1 << 11)) && IN(pb + 10)) for (int rep = 0; rep < (((REP >> 11) & 1) + 1); ++rep) { if (rep) __syncthreads(); if (USE_GATHER_PHASE) ph_gather(F, l); }
        if (USE_GATHER_PHASE) SEAM(pb + 10);
        const int RT = need_ctx ? 9 : 8;
        if (!(DIS & (1 << 12)) && IN(pb + 11)) for (int rep = 0; rep < (((REP >> 12) & 1) + 1); ++rep) { if (rep) __syncthreads();
            pg8::Gemm g{F.H(), F.WGU() + (size_t)l * 16 * 4096 * 2048, NEXP * RT * 256, NEXP * 4096, 2048, F.PTOK()}; MoeOrder S; S.init(RT, 16, F.G, F.vcu);
            EpiSwiGLU E{F.ACT(), 16};
            pg8::gemm_phase<EpiSwiGLU, MoeOrder, true, true, true, MOE_BAUX>(F.lds, g, S, E);
        }
        SEAM(pb + 11);
        if (!(DIS & (1 << 13)) && IN(pb + 12)) for (int rep = 0; rep < (((REP >> 13) & 1) + 1); ++rep) { if (rep) __syncthreads();
            pg8::Gemm g{F.ACT(), F.WD() + (size_t)l * 16 * 2048 * 2048, NEXP * RT * 256, NEXP * 2048, 2048};
            EpiDown E{F.Y(), F.PGV(), 8};
            const bool split = (F.G == 256) && need_ctx && (SIDE_MASK & 4); const int xcd = F.bid & 7, lid = F.bid >> 3, ngx = 29;
            if (!split || lid < ngx) { MoeOrder S; if (!split) S.init(RT, 8, F.G, F.vcu); else S.init(RT, 8, 8 * ngx, xcd * ngx + lid);
                pg8::gemm_phase<EpiDown, MoeOrder, true, true, false, MOE_BAUX>(F.lds, g, S, E); }
            else ph_convert_side(p, F, ngx, CVT_C0, CVT_C1);
        }
        SEAM(pb + 12);
    }
    if (!(DIS & (1 << 14)) && IN(NPHASE - 1)) { ph_norm1(p, F, NLAYER - 1, 2); }
#undef IN
#undef SEAM
#undef GRID_BAR
}

extern "C" void kernel_launch(void* const* d_in, const int* in_sizes, int n_in, void* d_out, int out_size, void* d_ws, size_t ws_size, hipStream_t stream) {
    static int grid = 0;
    if (grid == 0) {
        if (n_in != 24 || out_size != NB * 2048 * DM || ws_size < WS_END) {
            fprintf(stderr, "kernel_launch: built for 24 inputs, %d outputs, >= %zu workspace bytes; got n_in %d out %d ws %zu\n", NB * 2048 * DM, (size_t)WS_END, n_in, out_size, ws_size); grid = -1; return; }
        int dev = 0, cus = 0, per_cu = 0;
        if (hipGetDevice(&dev) != hipSuccess || hipDeviceGetAttribute(&cus, hipDeviceAttributeMultiprocessorCount, dev) != hipSuccess) { fprintf(stderr, "kernel_launch: device query failed\n"); grid = -1; return; }
        if (hipFuncSetAttribute((const void*)mk_fwd, hipFuncAttributeMaxDynamicSharedMemorySize, LDS_BYTES) != hipSuccess) { fprintf(stderr, "kernel_launch: hipFuncSetAttribute(%d) failed\n", LDS_BYTES); grid = -1; return; }
        if (hipOccupancyMaxActiveBlocksPerMultiprocessor(&per_cu, (const void*)mk_fwd, 512, LDS_BYTES) != hipSuccess || per_cu < 1)
            fprintf(stderr, "kernel_launch: note: occupancy query reports %d workgroups per CU\n", per_cu);
        (void)hipGetLastError();
        grid = cus;
        if (grid % 8 != 0 || grid < 64) fprintf(stderr, "kernel_launch: unexpected CU count %d\n", grid);
    }
    if (grid < 0) return;
    if (hipMemsetAsync((char*)d_ws + WS_CTL, 0, CTL_BYTES, stream) != hipSuccess) { fprintf(stderr, "kernel_launch: memset failed\n"); return; }
    Params p{};
    const float** pp = (const float**)&p;
    for (int i = 0; i < 24; ++i) pp[i] = (const float*)d_in[i];
    p.out = (float*)d_out; p.ws = (unsigned char*)d_ws;
#if MK_PER_PHASE
    for (int k = 0; k < NPHASE; ++k) { p.ph_lo = k; p.ph_hi = k + 1; hipLaunchKernelGGL(mk_fwd, dim3(grid), dim3(512), LDS_BYTES, stream, p); }
#else
    p.ph_lo = 0; p.ph_hi = NPHASE;
    hipLaunchKernelGGL(mk_fwd, dim3(grid), dim3(512), LDS_BYTES, stream, p);
#endif
    const hipError_t le = hipPeekAtLastError();
    if (le != hipSuccess) fprintf(stderr, "kernel_launch: launch failed: %s\n", hipGetErrorName(le));
}
```

```cpp
#include <hip/hip_runtime.h>
#include <cstdio>
#include <cstdint>
namespace pg8 {
#define PG8_LAS __attribute__((address_space(3)))
typedef unsigned short bf16_t;
typedef short bf16x8 __attribute__((ext_vector_type(8)));
typedef float f32x4 __attribute__((ext_vector_type(4)));
typedef unsigned u32x4 __attribute__((ext_vector_type(4)));
constexpr int BM = 256, BK = 64, HALF = 128, HTB = HALF * BK * 2  , STAGE_BYTES = 8 * HTB, NXCD = 8, WGM = 8;

__host__ __device__ __forceinline__ int lds_byte(int r, int c) { const int st = (r >> 4) * 2 + (c >> 5), rr = r & 15, cc = c & 31, ob = rr * 64 + cc * 2; return st * 1024 + (ob ^ (((ob >> 9) & 1) << 5)); }
__host__ __device__ __forceinline__ void stage_rc(int b, int& R, int& C) { const int st = b / 1024, sb = b % 1024, swz = sb ^ (((sb >> 9) & 1) << 5); R = (st >> 1) * 16 + swz / 64; C = (st & 1) * 32 + (swz % 64) / 2; }
__host__ __device__ __forceinline__ int perm32(int rho) { const int n = rho >> 4, i = rho & 15; return 8 * (i >> 2) + 4 * n + (i & 3); }

struct Unit { int pm, pn; };
struct Gemm { const bf16_t* A; const bf16_t* Bt; int M, N, K; const int* aidx; };
__device__ __forceinline__ unsigned cvt_pk_bf16(float lo, float hi) { unsigned r; asm volatile("v_cvt_pk_bf16_f32 %0, %1, %2" : "=v"(r) : "v"(lo), "v"(hi)); return r; }
template <class Epi, class Sched, bool ALIGN_EPI = false, bool SP2 = false, bool GATHER = false, int BAUX = 0>
__device__ __forceinline__ void gemm_phase(PG8_LAS unsigned char* lds, const Gemm g, const Sched& S, const Epi& E) {
    int tid_ = threadIdx.x; asm volatile("" : "+v"(tid_));
    const int tid = tid_, wid = __builtin_amdgcn_readfirstlane(tid >> 6), lane = tid & 63, wr = wid >> 2, wc = wid & 3, fr = lane & 15, fq = lane >> 4;
    const int K = g.K, nt = K / BK;
    unsigned voffA[2], voffB[2];
#pragma unroll
    for (int i = 0; i < 2; ++i) { int R, C; stage_rc(tid * 16 + i * 8192, R, C); const int Rb = Epi::PERM ? ((R & ~31) + perm32(R & 31)) : R;
        voffA[i] = (unsigned)(R * K + C) * 2u; voffB[i] = (unsigned)(Rb * K + C) * 2u; }
    static_assert(!GATHER || SP2, "GATHER is implemented for the SP2 loop only");
    unsigned gAc[2][2], gAn[2][2]; int gR[2], gC[2];
    PG8_LAS int* gtbl = (PG8_LAS int*)(lds + STAGE_BYTES);
    if constexpr (GATHER) {
#pragma unroll
        for (int i = 0; i < 2; ++i) stage_rc(tid * 16 + i * 8192, gR[i], gC[i]);
        Unit uu;
        for (int i = 0; i < 10 && S.next(i, uu); ++i) if (tid < 256) gtbl[i * 256 + tid] = g.aidx[uu.pm * BM + tid];
        __syncthreads();
#pragma unroll
        for (int h = 0; h < 2; ++h)
#pragma unroll
            for (int i = 0; i < 2; ++i) gAc[h][i] = (unsigned)gtbl[h * HALF + gR[i]] * (unsigned)(K * 2) + (unsigned)(gC[i] * 2);
    }
#define PG8_STAGE_A(bufoff, kptr, h, usenext) do { if constexpr (GATHER) { _Pragma("unroll") for (int _i = 0; _i < 2; ++_i) \
        __builtin_amdgcn_global_load_lds((const unsigned*)((const char*)(kptr) + ((usenext) ? gAn[h][_i] : gAc[h][_i])), (PG8_LAS unsigned*)(lds + (bufoff) + ldsw + _i * 8192), 16, 0, 0); } \
        else { PG8_STAGE(bufoff, (kptr) + (h) * hstep, voffA); } } while (0)
    const size_t kstep = (size_t)(BK * 2);
    const size_t hstep = (size_t)HALF * K * 2;
    const size_t tstep = 2 * hstep;
    const unsigned ldsw = (unsigned)wid * 1024u;
    const int aoff = lds_byte(wr * 64 + fr, fq * 8), boff = lds_byte(wc * 32 + fr, fq * 8);
#define PG8_SA(b, h) (((b) * 2 + (h)) * HTB)
#define PG8_SB(b, h) ((4 + (b) * 2 + (h)) * HTB)
#define PG8_STAGE(bufoff, gbase, voff) do { _Pragma("unroll") for (int _i = 0; _i < 2; ++_i) \
        __builtin_amdgcn_global_load_lds((const unsigned*)((const char*)(gbase) + (voff)[_i]), (PG8_LAS unsigned*)(lds + (bufoff) + ldsw + _i * 8192), 16, 0, 0); } while (0)
#define PG8_STAGE_B(bufoff, gbase, voff) do { _Pragma("unroll") for (int _i = 0; _i < 2; ++_i) \
        __builtin_amdgcn_global_load_lds((const unsigned*)((const char*)(gbase) + (voff)[_i]), (PG8_LAS unsigned*)(lds + (bufoff) + ldsw + _i * 8192), 16, 0, BAUX); } while (0)
#define PG8_LDA(dst, b, h) do { _Pragma("unroll") for (int m = 0; m < 4; ++m) _Pragma("unroll") for (int k = 0; k < 2; ++k) dst[m][k] = *(const PG8_LAS bf16x8*)(lds + PG8_SA(b, h) + aoff + m * 2048 + k * 1024); } while (0)
#define PG8_LDB(dst, b, h) do { _Pragma("unroll") for (int n = 0; n < 2; ++n) _Pragma("unroll") for (int k = 0; k < 2; ++k) dst[n][k] = *(const PG8_LAS bf16x8*)(lds + PG8_SB(b, h) + boff + n * 2048 + k * 1024); } while (0)
#define PG8_MMA(ai, bj, At, Bt) do { __builtin_amdgcn_s_setprio(1); _Pragma("unroll") for (int m = 0; m < 4; ++m) _Pragma("unroll") for (int n = 0; n < 2; ++n) _Pragma("unroll") for (int k = 0; k < 2; ++k) \
        acc[ai][bj][m][n] = __builtin_amdgcn_mfma_f32_16x16x32_bf16(Bt[n][k], At[m][k], acc[ai][bj][m][n], 0, 0, 0); __builtin_amdgcn_s_setprio(0); } while (0)
#define PG8_WAIT_V(n) asm volatile("s_waitcnt vmcnt(" #n ")" ::: "memory")
#define PG8_WAIT_L(n) asm volatile("s_waitcnt lgkmcnt(" #n ")" ::: "memory")
#define PG8_BAR __builtin_amdgcn_s_barrier()
#define PG8_SCHED __builtin_amdgcn_sched_barrier(0)
    Unit cur, nxt; int ui = 0;
    if (!S.next(0, cur)) return;
    f32x4 acc[2][2][4][2];
#pragma unroll
    for (int a = 0; a < 2; ++a)
#pragma unroll
        for (int b = 0; b < 2; ++b)
#pragma unroll
            for (int m = 0; m < 4; ++m)
#pragma unroll
                for (int n = 0; n < 2; ++n) acc[a][b][m][n] = (f32x4){0.f, 0.f, 0.f, 0.f};
    bf16x8 At[4][2], B0[2][2], B1[2][2];
    const char* cA = GATHER ? (const char*)g.A : (const char*)g.A + (size_t)cur.pm * tstep; const char* cB = (const char*)g.Bt + (size_t)cur.pn * tstep;
    S.a_ready(cur);
    if constexpr (SP2) {
        PG8_STAGE_B(PG8_SB(0, 0), cB, voffB); PG8_STAGE_B(PG8_SB(0, 1), cB + hstep, voffB); PG8_STAGE_A(PG8_SA(0, 0), cA, 0, false); PG8_STAGE_A(PG8_SA(0, 1), cA, 1, false);
        if (wr == 1) PG8_BAR;
        PG8_WAIT_V(2); PG8_BAR;
        PG8_STAGE_B(PG8_SB(1, 0), cB + kstep, voffB); PG8_STAGE_A(PG8_SA(1, 0), cA + kstep, 0, false); PG8_STAGE_B(PG8_SB(1, 1), cB + hstep + kstep, voffB);
        PG8_WAIT_V(6); PG8_BAR;
    } else {
        PG8_STAGE_B(PG8_SB(0, 0), cB, voffB); PG8_STAGE(PG8_SA(0, 0), cA, voffA); PG8_STAGE_B(PG8_SB(0, 1), cB + hstep, voffB); PG8_STAGE(PG8_SA(0, 1), cA + hstep, voffA);
        if (wr == 1) PG8_BAR;
        PG8_WAIT_V(4); PG8_BAR;
        PG8_STAGE_B(PG8_SB(1, 0), cB + kstep, voffB); PG8_STAGE(PG8_SA(1, 0), cA + kstep, voffA); PG8_STAGE_B(PG8_SB(1, 1), cB + hstep + kstep, voffB);
        PG8_WAIT_V(6); PG8_BAR;
    }
    for (;;) {
        const bool has_next = S.next(ui + 1, nxt);
        const char* nA = (has_next && !GATHER) ? (const char*)g.A + (size_t)nxt.pm * tstep : cA; const char* nB = has_next ? (const char*)g.Bt + (size_t)nxt.pn * tstep : cB;
        if constexpr (GATHER) {
#pragma unroll
            for (int h = 0; h < 2; ++h)
#pragma unroll
                for (int i = 0; i < 2; ++i) gAn[h][i] = has_next ? (unsigned)gtbl[(ui + 1) * 256 + h * HALF + gR[i]] * (unsigned)(K * 2) + (unsigned)(gC[i] * 2) : gAc[h][i];
        }
        for (int t = 0; t < nt; t += 2) {
            const bool last = (t == nt - 2);
            const char* a1 = cA + (size_t)(t + 1) * kstep;
            const char* a2 = last ? nA : cA + (size_t)(t + 2) * kstep; const char* b2 = last ? nB : cB + (size_t)(t + 2) * kstep;
            const char* a3 = a2 + kstep; const char* b3 = b2 + kstep;
            if (last && has_next) S.a_ready(nxt);
            if constexpr (SP2) {
            PG8_LDB(B0, 0, 0); PG8_LDB(B1, 0, 1); PG8_SCHED; PG8_LDA(At, 0, 0); PG8_STAGE_A(PG8_SA(1, 1), a1, 1, false);
            PG8_WAIT_V(8); PG8_WAIT_L(0); PG8_BAR; PG8_MMA(0, 0, At, B0); PG8_MMA(0, 1, At, B1); PG8_BAR; PG8_SCHED;
            PG8_LDA(At, 0, 1); PG8_STAGE_B(PG8_SB(0, 0), b2, voffB); PG8_STAGE_B(PG8_SB(0, 1), b2 + hstep, voffB); PG8_STAGE_A(PG8_SA(0, 0), a2, 0, last);
            PG8_WAIT_V(8); PG8_WAIT_L(0); PG8_BAR; PG8_MMA(1, 0, At, B0); PG8_MMA(1, 1, At, B1); PG8_BAR; PG8_SCHED;
            PG8_LDB(B0, 1, 0); PG8_LDB(B1, 1, 1); PG8_SCHED; PG8_LDA(At, 1, 0); PG8_STAGE_A(PG8_SA(0, 1), a2, 1, last);
            PG8_WAIT_V(8); PG8_WAIT_L(0); PG8_BAR; PG8_MMA(0, 0, At, B0); PG8_MMA(0, 1, At, B1); PG8_BAR; PG8_SCHED;
            PG8_LDA(At, 1, 1); PG8_STAGE_B(PG8_SB(1, 0), b3, voffB); PG8_STAGE_B(PG8_SB(1, 1), b3 + hstep, voffB); PG8_STAGE_A(PG8_SA(1, 0), a3, 0, last);
            PG8_WAIT_V(8); PG8_WAIT_L(0); PG8_BAR; PG8_MMA(1, 0, At, B0); PG8_MMA(1, 1, At, B1); PG8_BAR; PG8_SCHED;
            } else {
            PG8_LDB(B0, 0, 0); PG8_SCHED; PG8_LDA(At, 0, 0); PG8_STAGE(PG8_SA(1, 1), a1 + hstep, voffA);
            PG8_WAIT_L(8); PG8_BAR; PG8_WAIT_L(0); PG8_MMA(0, 0, At, B0); PG8_BAR; PG8_SCHED;
            PG8_LDB(B1, 0, 1); PG8_STAGE_B(PG8_SB(0, 0), b2, voffB);
            PG8_BAR; PG8_WAIT_L(0); PG8_MMA(0, 1, At, B1); PG8_BAR;
            PG8_LDA(At, 0, 1); PG8_STAGE(PG8_SA(0, 0), a2, voffA);
            PG8_BAR; PG8_WAIT_L(0); PG8_MMA(1, 0, At, B0); PG8_BAR; PG8_SCHED;
            PG8_STAGE_B(PG8_SB(0, 1), b2 + hstep, voffB);
            PG8_WAIT_V(6); PG8_BAR; PG8_MMA(1, 1, At, B1); PG8_BAR;
            PG8_LDB(B0, 1, 0); PG8_SCHED; PG8_LDA(At, 1, 0); PG8_STAGE(PG8_SA(0, 1), a2 + hstep, voffA);
            PG8_WAIT_L(8); PG8_BAR; PG8_WAIT_L(0); PG8_MMA(0, 0, At, B0); PG8_BAR; PG8_SCHED;
            PG8_LDB(B1, 1, 1); PG8_STAGE_B(PG8_SB(1, 0), b3, voffB);
            PG8_BAR; PG8_WAIT_L(0); PG8_MMA(0, 1, At, B1); PG8_BAR;
            PG8_LDA(At, 1, 1); PG8_STAGE(PG8_SA(1, 0), a3, voffA);
            PG8_BAR; PG8_WAIT_L(0); PG8_MMA(1, 0, At, B0); PG8_BAR; PG8_SCHED;
            PG8_STAGE_B(PG8_SB(1, 1), b3 + hstep, voffB);
            PG8_WAIT_V(6); PG8_BAR; PG8_MMA(1, 1, At, B1); PG8_BAR;
            }
        }
        if constexpr (ALIGN_EPI) { if (wr == 0) PG8_BAR; }
        if constexpr (!Epi::AFTER_DRAIN) { E(acc, cur, wr, wc, fr, fq); S.done(cur); }
        if (!has_next) break;
#pragma unroll
        for (int a = 0; a < 2; ++a)
#pragma unroll
            for (int b = 0; b < 2; ++b)
#pragma unroll
                for (int m = 0; m < 4; ++m)
#pragma unroll
                    for (int n = 0; n < 2; ++n) acc[a][b][m][n] = (f32x4){0.f, 0.f, 0.f, 0.f};
        cur = nxt; cA = nA; cB = nB; ++ui;
        if constexpr (GATHER) {
#pragma unroll
            for (int h = 0; h < 2; ++h)
#pragma unroll
                for (int i = 0; i < 2; ++i) gAc[h][i] = gAn[h][i]; }
        if constexpr (ALIGN_EPI) { if (wr == 1) PG8_BAR; }
    }
    PG8_WAIT_V(0);
    if constexpr (!ALIGN_EPI) { if (wr == 0) PG8_BAR; }
    PG8_BAR;
    if constexpr (Epi::AFTER_DRAIN) { E.fused(acc, cur, wr, wc, fr, fq, lds, wid, lane); S.done(cur); }
#undef PG8_SA
#undef PG8_SB
#undef PG8_STAGE
#undef PG8_STAGE_B
#undef PG8_STAGE_A
#undef PG8_LDA
#undef PG8_LDB
#undef PG8_MMA
#undef PG8_WAIT_V
#undef PG8_WAIT_L
#undef PG8_BAR
#undef PG8_SCHED
}
}
#define XB_TMO      128
#define XB_XCNT(j)  (256  + 64 * (j))
#define XB_XSUB(j)  (1280 + 64 * (j))
#define XB_XGEN(j)  (2304 + 64 * (j))
#define XB_TOP      3328
#define XB_TOPGEN   3392
#define XCD_BAR_WORDS 3456
#define XB_SPIN_CAP (1u << 18)
#define LAS __attribute__((address_space(3)))

__device__ __forceinline__ unsigned xb_ld(unsigned* p)              { return __hip_atomic_load(p, __ATOMIC_RELAXED, __HIP_MEMORY_SCOPE_AGENT); }
__device__ __forceinline__ unsigned xb_add(unsigned* p, unsigned v) { return __hip_atomic_fetch_add(p, v, __ATOMIC_RELAXED, __HIP_MEMORY_SCOPE_AGENT); }
__device__ __forceinline__ unsigned xb_xcc_id() { return (unsigned)__builtin_amdgcn_s_getreg((3 << 11) | 20) & 0xFu; }
#define XB_SPIN(cond, bar) do { unsigned _sp = 0; while (cond) { __builtin_amdgcn_s_sleep(1); \
    if ((++_sp & 255u) == 0u) { if (xb_ld(&(bar)[XB_TMO])) break; if (_sp > XB_SPIN_CAP) { atomicAdd(&(bar)[XB_TMO], 1u); break; } } } } while (0)

struct XcdBarrier {
    unsigned* bar; unsigned x;
    volatile LAS unsigned* st;
};

__device__ __forceinline__ XcdBarrier xcd_barrier_post(unsigned* bar, volatile LAS unsigned* st) {
    XcdBarrier b; b.bar = bar; b.x = xb_xcc_id(); b.st = st;
    if (threadIdx.x == 0) (void)xb_add(&bar[XB_XCNT(b.x)], 1u);
    return b;
}
__device__ __forceinline__ void xcd_barrier_complete(unsigned* bar, unsigned x, unsigned& nloc, unsigned& nx) {
    const unsigned G = gridDim.x * gridDim.y * gridDim.z;
    unsigned sum, cnt, mine, sp = 0u;
    for (;;) {
        sum = 0u; cnt = 0u; mine = 0u;
#pragma unroll
        for (unsigned j = 0; j < 16; ++j) { const unsigned c = xb_ld(&bar[XB_XCNT(j)]); sum += c; cnt += (c > 0u) ? 1u : 0u; mine = (j == x) ? c : mine; }
        if (sum == G) break;
        __builtin_amdgcn_s_sleep(1);
        if ((++sp & 255u) == 0u) { if (xb_ld(&bar[XB_TMO])) break; if (sp > XB_SPIN_CAP) { atomicAdd(&bar[XB_TMO], 1u); break; } }
    }
    nloc = mine > 0u ? mine : 1u; nx = cnt > 0u ? cnt : 1u;
}

__device__ __forceinline__ void xcd_barrier(const XcdBarrier& b) {
    asm volatile("s_waitcnt vmcnt(0)" ::: "memory");
    __syncthreads();
    if (threadIdx.x == 0) {
        unsigned* bar = b.bar;
        __builtin_amdgcn_s_waitcnt(0);
        unsigned nloc = b.st[0], nx = b.st[1];
        if (nloc == 0u) { xcd_barrier_complete(bar, b.x, nloc, nx); b.st[0] = nloc; b.st[1] = nx; }
        const unsigned old = xb_add(&bar[XB_XSUB(b.x)], 1u);
        const unsigned gen = old / nloc;
        if (old + 1u == (gen + 1u) * nloc) {
            __builtin_amdgcn_fence(__ATOMIC_RELEASE, "agent");
            asm volatile("s_waitcnt vmcnt(0)" ::: "memory");
            const unsigned og = xb_add(&bar[XB_TOP], 1u);
            const unsigned tg = og / nx;
            if (og + 1u == (tg + 1u) * nx) xb_add(&bar[XB_TOPGEN], 1u);
            else XB_SPIN(xb_ld(&bar[XB_TOPGEN]) == tg, bar);
            __builtin_amdgcn_fence(__ATOMIC_ACQUIRE, "agent");
            xb_add(&bar[XB_XGEN(b.x)], 1u);
            asm volatile("s_waitcnt vmcnt(0)" ::: "memory");
        } else {
            XB_SPIN(xb_ld(&bar[XB_XGEN(b.x)]) == gen, bar);
            __builtin_amdgcn_fence(__ATOMIC_ACQUIRE, "agent");
            asm volatile("s_waitcnt vmcnt(0)" ::: "memory");
        }
    }
    __syncthreads();
}

#ifndef DIS
#define DIS 0
#endif
#ifndef SIDE_MASK
#define SIDE_MASK 15
#endif
#ifndef USE_GATHER_PHASE
#define USE_GATHER_PHASE 0
#endif
#ifndef CVT_NA
#define CVT_NA 325
#define CVT_NB 256
#define CVT_NC 47
#define CVT_ND 50
#endif
#ifndef CVT_TKQ
#define CVT_TKQ 0
#endif
#ifndef PRO_SPLIT
#define PRO_SPLIT 0
#endif
#ifndef CVT_MQ0
#define CVT_MQ0 160
#define CVT_MQ1 160
#endif
#ifndef MP_IN_MIXER
#define MP_IN_MIXER 0
#endif
#ifndef MO_IN_MIXER
#define MO_IN_MIXER 1
#endif
#ifndef PROBE_NACT
#define PROBE_NACT -1
#endif
#ifndef ATT_PRIO
#define ATT_PRIO 0
#endif
#ifndef ATT_G2
#define ATT_G2 0
#endif
#ifndef ATT_PD
#define ATT_PD 2
#endif
#ifndef GQA_SPLIT
#define GQA_SPLIT 0
#endif
#ifndef CVT_PRO8
#define CVT_PRO8 1
#endif
#ifndef CVT_SIDE8
#define CVT_SIDE8 1
#endif
#ifndef RPROBE1
#define RPROBE1 0
#define RPROBE2 0
#endif
#ifndef ROUTER_MFMA
#define ROUTER_MFMA 0
#endif
#ifndef ATTN_BODY
#define ATTN_BODY attn_body_sp
#endif
#ifndef MOE_ORDER_ALT
#define MOE_ORDER_ALT 1
#endif
#ifndef RPROBE_SKIP
#define RPROBE_SKIP 0
#endif
#ifndef CVT_NT_LOADS
#define CVT_NT_LOADS 1
#endif
#ifndef MOE_BAUX
#define MOE_BAUX 0
#endif
#ifndef REP
#define REP 0
#endif
typedef unsigned short bf16_t;
typedef short bf16x8 __attribute__((ext_vector_type(8)));
typedef short s16x4 __attribute__((ext_vector_type(4)));
typedef float f32x4 __attribute__((ext_vector_type(4)));
typedef float f32x16 __attribute__((ext_vector_type(16)));
typedef unsigned u32x4 __attribute__((ext_vector_type(4)));
typedef unsigned u32x2 __attribute__((ext_vector_type(2)));
using pg8::cvt_pk_bf16;

constexpr int DM = 2048, NB = 8, TPB = 2304  , NTOK = NB * TPB, NLAYER = 2;
constexpr int NPW = 4608;
constexpr int NEXP = 16;
constexpr float EPSN = 1e-6f;
constexpr float QSCALE_G = 0.08838834764831845f * 1.4426950408889634f;
constexpr float QSCALE_M = 0.07216878364870323f * 1.4426950408889634f;
constexpr int LDS_BYTES = 155648;
constexpr int LDS_MISC = LDS_BYTES - 64;

constexpr size_t al256(size_t x) { return (x + 255) / 256 * 256; }
constexpr size_t WS_CTL = 0;
constexpr size_t CTL_BYTES = 65536;
constexpr size_t CTL_Q = 16384;
constexpr size_t WS_MOD = WS_CTL + CTL_BYTES;
constexpr size_t WS_ROPEG = WS_MOD + al256((size_t)2 * 9 * 12288 * 4);
constexpr size_t WS_ROPEM = WS_ROPEG + (size_t)2048 * 64 * 2 * 4;
constexpr size_t WS_GI = WS_ROPEM + (size_t)2048 * 32 * 2 * 4;
constexpr size_t WS_GF = WS_GI + (size_t)2 * 8 * 4 * 2304 * 4;
constexpr size_t WS_AFF = WS_GF + (size_t)2 * 8 * 4 * 2304 * 4;
constexpr size_t WS_PTOK = WS_AFF + (size_t)8 * 16 * 2304 * 4;
constexpr size_t WS_PGV = WS_PTOK + (size_t)36864 * 4;
constexpr size_t WS_TOKSLOT = WS_PGV + (size_t)36864 * 4;
constexpr size_t WS_WIN = al256(WS_TOKSLOT + (size_t)NTOK * 16 * 4);
constexpr size_t WS_WOUT = WS_WIN + (size_t)2 * NPW * 2048 * 2;
constexpr size_t WS_WUQ = WS_WOUT + (size_t)2 * 2048 * 2048 * 2;
constexpr size_t WS_WUKV = WS_WUQ + (size_t)2 * 768 * 512 * 2;
constexpr size_t WS_WGU = WS_WUKV + (size_t)2 * 1024 * 256 * 2;
constexpr size_t WS_WD = WS_WGU + (size_t)2 * 16 * 4096 * 2048 * 2;
constexpr size_t WS_X = WS_WD + (size_t)2 * 16 * 2048 * 2048 * 2;
constexpr size_t WS_H = WS_X + (size_t)NTOK * 2048 * 4;
constexpr size_t WS_P = WS_H + (size_t)NTOK * 2048 * 2;
constexpr size_t WS_PG = WS_P + (size_t)NTOK * NPW * 2;
constexpr size_t WS_QG = WS_PG + (size_t)NTOK * 128 * 4;
constexpr size_t WS_KG = WS_QG + (size_t)NTOK * 1024 * 2;
constexpr size_t WS_QA = WS_KG + (size_t)NTOK * 256 * 2;
constexpr size_t WS_KVA = WS_QA + (size_t)NTOK * 512 * 2;
constexpr size_t WS_MQ = WS_KVA + (size_t)NTOK * 256 * 2;
constexpr size_t WS_MKV = WS_MQ + (size_t)NTOK * 768 * 2;
constexpr size_t WS_QM = WS_MKV + (size_t)NTOK * 1024 * 2;
constexpr size_t WS_KM = WS_QM + (size_t)NTOK * 768 * 2;
constexpr size_t WS_HF = WS_KM + (size_t)NTOK * 768 * 2;
constexpr size_t WS_HB = WS_HF + (size_t)NTOK * 512 * 4;
constexpr size_t WS_MIX = WS_HB + (size_t)NTOK * 512 * 4;
constexpr size_t WS_END = WS_MIX + (size_t)NTOK * 2048 * 2;
constexpr size_t WS_XG = WS_P, WS_ACT = WS_QG, WS_Y = WS_HF;
static_assert(WS_END <= (size_t)2147483648ull, "workspace map exceeds 2 GiB");
static_assert((size_t)36864 * 2048 * 2 <= (size_t)NTOK * NPW * 2, "XG overlay");
static_assert(WS_ACT + (size_t)36864 * 2048 * 2 <= WS_HF, "ACT overlay");
static_assert(WS_Y + (size_t)36864 * 2048 * 2 <= WS_END, "Y overlay");

struct Params {
    const float *x, *c, *ctx, *c_ctx, *ada_w, *ada_b, *norm1, *norm2, *w_in, *b_gates, *ml_norm, *gqa_q_norm, *gqa_k_norm, *mla_qa_norm, *mla_kva_norm,
                *mla_w_uq, *mla_w_ukv, *mla_q_norm, *mla_k_norm, *w_out, *w_router, *w_gate, *w_up, *w_down;
    float* out; unsigned char* ws; int ph_lo, ph_hi;
};

__device__ __forceinline__ float bflo(unsigned w) { return __uint_as_float(w << 16); }
__device__ __forceinline__ float bfhi(unsigned w) { return __uint_as_float(w & 0xffff0000u); }
__device__ __forceinline__ float wsum64(float v) { v += __shfl_xor(v, 32); v += __shfl_xor(v, 16); v += __shfl_xor(v, 8); v += __shfl_xor(v, 4); v += __shfl_xor(v, 2); v += __shfl_xor(v, 1); return v; }
__device__ __forceinline__ float gsum16(float v) { v += __shfl_xor(v, 8); v += __shfl_xor(v, 4); v += __shfl_xor(v, 2); v += __shfl_xor(v, 1); return v; }
__device__ __forceinline__ void unpack8(const u32x4 w, float (&f)[8]) { f[0] = bflo(w.x); f[1] = bfhi(w.x); f[2] = bflo(w.y); f[3] = bfhi(w.y); f[4] = bflo(w.z); f[5] = bfhi(w.z); f[6] = bflo(w.w); f[7] = bfhi(w.w); }
__device__ __forceinline__ u32x4 pack8(const float (&f)[8]) { u32x4 w; w.x = cvt_pk_bf16(f[0], f[1]); w.y = cvt_pk_bf16(f[2], f[3]); w.z = cvt_pk_bf16(f[4], f[5]); w.w = cvt_pk_bf16(f[6], f[7]); return w; }
template <int OFF> __device__ __forceinline__ s16x4 tr_read(unsigned addr) {
    s16x4 r; asm volatile("ds_read_b64_tr_b16 %0, %1 offset:%2" : "=&v"(r) : "v"(addr), "i"(OFF) : "memory"); return r;
}
#define LGKM0() do { asm volatile("s_waitcnt lgkmcnt(0)" ::: "memory"); __builtin_amdgcn_sched_barrier(0); } while (0)
#define PK8(L, H) (bf16x8){L[0], L[1], L[2], L[3], H[0], H[1], H[2], H[3]}
namespace att {
constexpr int NW = 8, QBLK = 32, KVBLK = 64;
constexpr float THR_L2 = 11.5f;
template <int DQK> struct Cfg {
    static constexpr int KP = DQK / 8;
    static constexpr int NKP = 64 * KP / 512;
    static constexpr int QSP = 0;
    static constexpr int KPITCH = DQK == 128 ? 256 : 512;
    static constexpr int SHM_V = KVBLK * 128 * 2, SHM_K = KVBLK * KPITCH, OFF_QSP = 2 * SHM_V + 2 * SHM_K + NW * 64 * 4, SHM = OFF_QSP + NW * QSP * 1024;
};
#define SBAR() __builtin_amdgcn_sched_barrier(0)
__device__ __forceinline__ int crow(int r, int hi) { return (r & 3) + 8 * (r >> 2) + 4 * hi; }
__device__ __forceinline__ void partialSM(f32x16& p0, f32x16& p1, float& m_reg, float& mn, float& alpha) {
    float pmax = p0[0];
#pragma unroll
    for (int r = 1; r < 16; ++r) pmax = fmaxf(pmax, p0[r]);
#pragma unroll
    for (int r = 0; r < 16; ++r) pmax = fmaxf(pmax, p1[r]);
    { auto rr = __builtin_amdgcn_permlane32_swap(__float_as_uint(pmax), __float_as_uint(pmax), false, false);
      pmax = fmaxf(__uint_as_float(rr[0]), __uint_as_float(rr[1])); }
    if (__builtin_expect(__all(pmax - m_reg <= THR_L2), 1)) { mn = m_reg; alpha = 1.f; }
    else { mn = fmaxf(m_reg, pmax); alpha = __builtin_amdgcn_exp2f(m_reg - mn); m_reg = mn; }
#pragma unroll
    for (int r = 0; r < 16; ++r) p0[r] = p0[r] - mn;
#pragma unroll
    for (int r = 0; r < 16; ++r) p1[r] = p1[r] - mn;
#pragma unroll
    for (int r = 0; r < 16; ++r) p0[r] = __builtin_amdgcn_exp2f(p0[r]);
}
__device__ __forceinline__ void finishSM(f32x16& p0, f32x16& p1, float alpha, float& l_reg, bf16x8& pa0, bf16x8& pa1, bf16x8& pa2, bf16x8& pa3) {
#pragma unroll
    for (int r = 0; r < 16; ++r) p1[r] = __builtin_amdgcn_exp2f(p1[r]);
    float ps = 0;
#pragma unroll
    for (int r = 0; r < 16; ++r) ps += p0[r];
#pragma unroll
    for (int r = 0; r < 16; ++r) ps += p1[r];
    { auto rr = __builtin_amdgcn_permlane32_swap(__float_as_uint(ps), __float_as_uint(ps), false, false);
      ps = __uint_as_float(rr[0]) + __uint_as_float(rr[1]); }
    l_reg = l_reg * alpha + ps;
#define PK4(P, BASE, OUT) do { unsigned a0 = cvt_pk_bf16(P[BASE + 0], P[BASE + 1]), a1 = cvt_pk_bf16(P[BASE + 2], P[BASE + 3]);   \
    unsigned b0 = cvt_pk_bf16(P[BASE + 4], P[BASE + 5]), b1 = cvt_pk_bf16(P[BASE + 6], P[BASE + 7]);                              \
    auto r0 = __builtin_amdgcn_permlane32_swap(a0, b0, false, false); auto r1 = __builtin_amdgcn_permlane32_swap(a1, b1, false, false); \
    u32x4 w = {r0[0], r1[0], r0[1], r1[1]}; OUT = *reinterpret_cast<bf16x8*>(&w); } while (0)
    PK4(p0, 0, pa0); PK4(p0, 8, pa1); PK4(p1, 0, pa2); PK4(p1, 8, pa3);
#undef PK4
}
template <int DQK> __device__ __forceinline__ int kswz(int row, int colB) { return row * Cfg<DQK>::KPITCH + (colB ^ ((row & 15) << 4)); }
template <int DQK> __device__ __forceinline__ void qkt(f32x16& p0, f32x16& p1, const LAS unsigned char* Ks, const bf16x8* qr, const LAS unsigned char* qsp, int r32, int hi) {
    constexpr int NR = DQK / 16 - Cfg<DQK>::QSP;
    p0 = f32x16{}; p1 = f32x16{};
#pragma unroll
    for (int d0 = 0; d0 < DQK / 16; ++d0) { const int cb = (d0 * 16 + hi * 8) * 2;
        const bf16x8 b0 = *(const LAS bf16x8*)(Ks + kswz<DQK>(r32, cb));
        const bf16x8 b1 = *(const LAS bf16x8*)(Ks + kswz<DQK>(32 + r32, cb));
        bf16x8 qf;
        if (d0 < NR) qf = qr[d0 < NR ? d0 : 0]; else qf = *(const LAS bf16x8*)(qsp + (d0 - NR) * 1024);
        p0 = __builtin_amdgcn_mfma_f32_32x32x16_bf16(b0, qf, p0, 0, 0, 0);
        p1 = __builtin_amdgcn_mfma_f32_32x32x16_bf16(b1, qf, p1, 0, 0, 0);
        if (DQK > 128 && (d0 & 3) == 3 && d0 + 1 < DQK / 16) SBAR(); }
}
__device__ __forceinline__ int v_st(int k, int c) { const int kk = (k & ~0xC) | ((k & 4) << 1) | ((k & 8) >> 1); return ((kk >> 3) * 4 + (c >> 5)) * 512 + ((kk & 7) * 32 + (c & 31)) * 2; }
__device__ __forceinline__ int v_rd_base(int lane) { return ((lane & 3) << 3) | (((lane >> 2) & 3) << 6) | (((lane >> 4) & 1) << 5) | (((lane >> 5) & 1) << 8); }
constexpr int v_rd_off(int d0, int ks, int half) { return d0 * 512 + ks * 4096 + half * 2048; }
template <int D0> __device__ __forceinline__ void pv_one(f32x16& od, unsigned vb, bf16x8 pa0, bf16x8 pa1, bf16x8 pa2, bf16x8 pa3) {
    const s16x4 l0 = tr_read<v_rd_off(D0, 0, 0)>(vb), h0 = tr_read<v_rd_off(D0, 0, 1)>(vb), l1 = tr_read<v_rd_off(D0, 1, 0)>(vb), h1 = tr_read<v_rd_off(D0, 1, 1)>(vb);
    const s16x4 l2 = tr_read<v_rd_off(D0, 2, 0)>(vb), h2 = tr_read<v_rd_off(D0, 2, 1)>(vb), l3 = tr_read<v_rd_off(D0, 3, 0)>(vb), h3 = tr_read<v_rd_off(D0, 3, 1)>(vb);
    asm volatile("s_waitcnt lgkmcnt(0)" ::: "memory"); SBAR();
    od = __builtin_amdgcn_mfma_f32_32x32x16_bf16(pa0, PK8(l0, h0), od, 0, 0, 0);
    od = __builtin_amdgcn_mfma_f32_32x32x16_bf16(pa1, PK8(l1, h1), od, 0, 0, 0);
    od = __builtin_amdgcn_mfma_f32_32x32x16_bf16(pa2, PK8(l2, h2), od, 0, 0, 0);
    od = __builtin_amdgcn_mfma_f32_32x32x16_bf16(pa3, PK8(l3, h3), od, 0, 0, 0);
}
__device__ __forceinline__ void pv_d0(f32x16* o, unsigned vb, bf16x8 pa0, bf16x8 pa1, bf16x8 pa2, bf16x8 pa3) {
    pv_one<0>(o[0], vb, pa0, pa1, pa2, pa3); pv_one<1>(o[1], vb, pa0, pa1, pa2, pa3); pv_one<2>(o[2], vb, pa0, pa1, pa2, pa3); pv_one<3>(o[3], vb, pa0, pa1, pa2, pa3);
}

template <int DQK, int SDEPTH, int ldq, int ldk, int ldv, int ldo>
__device__ __forceinline__ void attn_body(const bf16_t* __restrict__ Qb, const bf16_t* __restrict__ Kh, const bf16_t* __restrict__ Vh,
                                          bf16_t* __restrict__ Ob, int seq, LAS unsigned char* lds) {
    using C = Cfg<DQK>;
    constexpr int SHM_V = C::SHM_V, SHM_K = C::SHM_K, NKP = C::NKP, KP = C::KP;
    int tid_ = threadIdx.x; asm volatile("" : "+v"(tid_));
    const int tid = tid_, wid = tid >> 6, lane = tid & 63, r32 = lane & 31, hi = lane >> 5;
    LAS unsigned char* V_lds = lds; LAS unsigned char* K_lds = lds + 2 * SHM_V;
    LAS float* ws = (LAS float*)(lds + 2 * SHM_V + 2 * SHM_K) + wid * 64; LAS float* li_l = ws; LAS float* al_l = ws + 32;
    constexpr int NR = DQK / 16 - C::QSP;
    float m_reg = -1e30f, l_reg = 0; f32x16 o[4] = {}; bf16x8 qr[NR];
    const bf16_t* Qw = Qb + (long)(wid * QBLK + r32) * ldq + hi * 8;
#pragma unroll
    for (int d0 = 0; d0 < NR; ++d0) qr[d0] = *(const bf16x8*)(Qw + d0 * 16);
    LAS unsigned char* qsp = lds + C::OFF_QSP + wid * (C::QSP * 1024) + lane * 16;
#pragma unroll
    for (int d0 = NR; d0 < DQK / 16; ++d0) *(LAS bf16x8*)(qsp + (d0 - NR) * 1024) = *(const bf16x8*)(Qw + d0 * 16);
    const int sr = tid >> 4, sc = (tid & 15) * 8, vst0 = v_st(sr, sc), vst1 = v_st(32 + sr, sc);
    const int krow = tid >> 3, kc16 = tid & 7;
    const int kst = krow * (DQK * 2) + ((kc16 * 16) ^ ((krow & 7) << 4));
    const unsigned vb0 = (unsigned)(uintptr_t)V_lds + (unsigned)v_rd_base(lane);
    struct { bf16x8 vs0, vs1, ks[NKP]; } sr_[SDEPTH];
    const __amdgpu_buffer_rsrc_t rsK = __builtin_amdgcn_make_buffer_rsrc((void*)Kh, (short)0, 0x7ffffff0, 0x00020000);
    const __amdgpu_buffer_rsrc_t rsV = __builtin_amdgcn_make_buffer_rsrc((void*)Vh, (short)0, 0x7ffffff0, 0x00020000);
    const int voffK = (krow * ldk + kc16 * 8) * 2, voffV = (sr * ldv + sc) * 2;
#define SLOAD(i, k0) do { { const u32x4 _t = __builtin_amdgcn_raw_buffer_load_b128(rsV, voffV, (k0) * (ldv * 2), 0); sr_[i].vs0 = *(const bf16x8*)&_t; } \
    { const u32x4 _t = __builtin_amdgcn_raw_buffer_load_b128(rsV, voffV, ((k0) + 32) * (ldv * 2), 0); sr_[i].vs1 = *(const bf16x8*)&_t; } \
    _Pragma("unroll") for (int _q = 0; _q < NKP; ++_q) { const u32x4 _t = __builtin_amdgcn_raw_buffer_load_b128(rsK, voffK, (k0) * (ldk * 2) + _q * 128, 0); sr_[i].ks[_q] = *(const bf16x8*)&_t; } } while (0)
#define SWRITE(b, i) do { *(LAS bf16x8*)(V_lds + (b) * SHM_V + vst0) = sr_[i].vs0; *(LAS bf16x8*)(V_lds + (b) * SHM_V + vst1) = sr_[i].vs1; \
    _Pragma("unroll") for (int _q = 0; _q < NKP; ++_q) *(LAS bf16x8*)(K_lds + (b) * SHM_K + kst + _q * 128) = sr_[i].ks[_q]; } while (0)
#define SWAIT() do { if constexpr (SDEPTH == 2) asm volatile("s_waitcnt vmcnt(%0)" :: "n"(2 + NKP) : "memory"); else asm volatile("s_waitcnt vmcnt(0)" ::: "memory"); } while (0)
#define RESC(a) do { if (__any((a) < 1.f)) { int _t2 = threadIdx.x; asm volatile("" : "+v"(_t2));   \
    LAS float* _al = (LAS float*)(lds + 2 * SHM_V + 2 * SHM_K) + (_t2 >> 6) * 64 + 32; const int _r2 = _t2 & 31, _h2 = (_t2 >> 5) & 1; \
    if (_h2 == 0) _al[_r2] = (a); asm volatile("s_waitcnt lgkmcnt(0)" ::: "memory"); \
    _Pragma("unroll") for (int d = 0; d < 4; ++d) _Pragma("unroll") for (int r = 0; r < 16; ++r) o[d][r] *= _al[crow(r, _h2)]; } } while (0)
    f32x16 pA0, pA1, pB0, pB1; float mnA, mnB, alA, alB; bf16x8 pa0, pa1, pa2, pa3; const int NT = seq / KVBLK;
    constexpr int SE = 0, SO = SDEPTH - 1;
    SLOAD(SE, 0); asm volatile("s_waitcnt vmcnt(0)" ::: "memory"); SWRITE(0, SE); __syncthreads();
    qkt<DQK>(pA0, pA1, K_lds, qr, qsp, r32, hi); partialSM(pA0, pA1, m_reg, mnA, alA);
    SLOAD(SO, KVBLK); if constexpr (SDEPTH == 2) { if (2 < NT) SLOAD(SE, 2 * KVBLK); }
    SWAIT(); SWRITE(1, SO); __syncthreads();
    for (int j = 1; j + 1 < NT; j += 2) {
        SBAR(); qkt<DQK>(pB0, pB1, K_lds + SHM_K, qr, qsp, r32, hi);
        finishSM(pA0, pA1, alA, l_reg, pa0, pa1, pa2, pa3); SBAR();
        SLOAD(SO, (j + SDEPTH) * KVBLK); SBAR();
        pv_d0(o, vb0, pa0, pa1, pa2, pa3); partialSM(pB0, pB1, m_reg, mnB, alB);
        __syncthreads(); SWAIT(); SWRITE(0, SE);
        RESC(alB); __syncthreads();
        SBAR(); qkt<DQK>(pA0, pA1, K_lds, qr, qsp, r32, hi);
        finishSM(pB0, pB1, alB, l_reg, pa0, pa1, pa2, pa3); SBAR();
        if (SDEPTH == 1 || j + 3 < NT) SLOAD(SE, (j + 1 + SDEPTH) * KVBLK); SBAR();
        pv_d0(o, vb0 + (unsigned)SHM_V, pa0, pa1, pa2, pa3); partialSM(pA0, pA1, m_reg, mnA, alA);
        __syncthreads(); SWAIT(); SWRITE(1, SO);
        RESC(alA); __syncthreads();
    }
    SBAR(); qkt<DQK>(pB0, pB1, K_lds + SHM_K, qr, qsp, r32, hi);
    finishSM(pA0, pA1, alA, l_reg, pa0, pa1, pa2, pa3); SBAR();
    pv_d0(o, vb0, pa0, pa1, pa2, pa3); partialSM(pB0, pB1, m_reg, mnB, alB);
    __syncthreads(); RESC(alB);
    finishSM(pB0, pB1, alB, l_reg, pa0, pa1, pa2, pa3); SBAR();
    pv_d0(o, vb0 + (unsigned)SHM_V, pa0, pa1, pa2, pa3);
    {
        int t3 = threadIdx.x; asm volatile("" : "+v"(t3));
        const int wid3 = t3 >> 6, r3 = t3 & 31, h3 = (t3 >> 5) & 1, odd = t3 & 1;
        LAS float* li3 = (LAS float*)(lds + 2 * SHM_V + 2 * SHM_K) + wid3 * 64;
        if (h3 == 0) li3[r3] = l_reg; asm volatile("s_waitcnt lgkmcnt(0)" ::: "memory");
        float rli[16];
#pragma unroll
        for (int r = 0; r < 16; ++r) rli[r] = __builtin_amdgcn_rcpf(li3[crow(r, h3)]);
        bf16_t* Ow = Ob + (long)(wid3 * QBLK) * ldo + (r3 & ~1);
#pragma unroll
        for (int r = 0; r < 16; r += 2) {
#pragma unroll
            for (int d0 = 0; d0 < 4; ++d0) {
                const float a = o[d0][r] * rli[r], bq = o[d0][r + 1] * rli[r + 1];
                const float xs = odd ? a : bq;
                const float y = __uint_as_float((unsigned)__builtin_amdgcn_update_dpp(0, (int)__float_as_uint(xs), 0xB1, 0xF, 0xF, true));
                const int orow = odd ? crow(r + 1, h3) : crow(r, h3);
                const unsigned w = odd ? cvt_pk_bf16(y, bq) : cvt_pk_bf16(a, y);
                *(unsigned*)(Ow + (long)orow * ldo + d0 * 32) = w;
            }
        }
    }
#undef SLOAD
#undef SWRITE
#undef SWAIT
#undef RESC
}

#define FX_CHUNK(P, G) do { const float _e0 = __builtin_amdgcn_exp2f(P[2 * (G)]), _e1 = __builtin_amdgcn_exp2f(P[2 * (G) + 1]); asm volatile("v_add_f32 %0, %0, %1" : "+v"(psa) : "v"(_e0)); asm volatile("v_add_f32 %0, %0, %1" : "+v"(psb) : "v"(_e1)); cv[G] = cvt_pk_bf16(_e0, _e1); } while (0)
#define FX_PACK(PA, B) do { auto _r0 = __builtin_amdgcn_permlane32_swap(cv[B], cv[(B) + 2], false, false); auto _r1 = __builtin_amdgcn_permlane32_swap(cv[(B) + 1], cv[(B) + 3], false, false); \
    u32x4 _w = {_r0[0], _r1[0], _r0[1], _r1[1]}; PA = *reinterpret_cast<bf16x8*>(&_w); } while (0)
#define FX_VRD(T) do { constexpr int _s = (T) % (PD + 1), _d = (T) & 3, _k = (T) >> 2; vl[_s] = tr_read<v_rd_off(_d, _k, 0)>(vb); vh[_s] = tr_read<v_rd_off(_d, _k, 1)>(vb); } while (0)
#define FX_PV(T) do { constexpr int _s = (T) % (PD + 1), _d = (T) & 3, _k = (T) >> 2, _nw = 2 * ((15 - (T)) < PD ? (15 - (T)) : PD); \
    asm volatile("s_waitcnt lgkmcnt(%2)" : "+v"(vl[_s]), "+v"(vh[_s]) : "n"(_nw) : "memory"); \
    o[_d] = __builtin_amdgcn_mfma_f32_32x32x16_bf16(pa[_k], PK8(vl[_s], vh[_s]), o[_d], 0, 0, 0); } while (0)
#define FX_GAP(T, EXTRA) do { if constexpr ((T) + PD < 16) { FX_VRD(((T) + PD) & 15); } FX_PV(T); EXTRA; SBAR(); } while (0)
template <int DQK, class ST>
__device__ __forceinline__ void tile_fx(f32x16 (&o)[4], float& l_reg, const LAS unsigned char* Kb, const unsigned vb, const bf16x8 (&qr)[DQK / 16], const int r32, const int hi, const ST& st) {
    constexpr int ND = DQK / 16, NS = 2 * ND, PD = ATT_PD;
    static_assert(PD >= 2 && PD <= 4, "prefetch distance");
    f32x16 p0 = f32x16{}, p1 = f32x16{};
    bf16x8 kf[PD + 1], pa[4]; s16x4 vl[PD + 1], vh[PD + 1]; unsigned cv[8]; float psa = 0.f, psb = 0.f;
#define FX_KRD(S) (*(const LAS bf16x8*)(Kb + kswz<DQK>(((S) < ND ? 0 : 32) + r32, (((S) < ND ? (S) : (S) - ND) * 16 + hi * 8) * 2)))
#pragma unroll
    for (int s = 0; s < PD; ++s) kf[s] = FX_KRD(s);
#pragma unroll
    for (int s = 0; s < NS; ++s) {
        if (s + PD < NS) kf[(s + PD) % (PD + 1)] = FX_KRD(s + PD);
        if (s < ND) p0 = __builtin_amdgcn_mfma_f32_32x32x16_bf16(kf[s % (PD + 1)], qr[s], p0, 0, 0, 0);
        else { const int g = s - ND;
            p1 = __builtin_amdgcn_mfma_f32_32x32x16_bf16(kf[s % (PD + 1)], qr[g], p1, 0, 0, 0);
            if (g < 8) FX_CHUNK(p0, g);
            if (g == 4) FX_PACK(pa[0], 0);
            if (g == (ND == 8 ? 7 : 8)) FX_PACK(pa[1], 4); }
        if (s == NS - 4 && PD >= 4) FX_VRD(PD - 4);
        if (s == NS - 3 && PD >= 3) FX_VRD(PD - 3);
        if (s == NS - 2) FX_VRD(PD - 2);
        if (s == NS - 1) FX_VRD(PD - 1);
        SBAR();
    }
#undef FX_KRD
    FX_GAP(0, FX_CHUNK(p1, 0)); FX_GAP(1, FX_CHUNK(p1, 1)); FX_GAP(2, FX_CHUNK(p1, 2)); FX_GAP(3, FX_CHUNK(p1, 3));
    FX_GAP(4, FX_CHUNK(p1, 4); FX_PACK(pa[2], 0)); FX_GAP(5, FX_CHUNK(p1, 5)); FX_GAP(6, FX_CHUNK(p1, 6)); FX_GAP(7, FX_CHUNK(p1, 7));
    FX_GAP(8, FX_PACK(pa[3], 4));
    FX_GAP(9, { float ps = psa + psb; auto rr = __builtin_amdgcn_permlane32_swap(__float_as_uint(ps), __float_as_uint(ps), false, false); l_reg += __uint_as_float(rr[0]) + __uint_as_float(rr[1]); });
    FX_GAP(10, st(0)); FX_GAP(11, st(1)); FX_GAP(12, st(2)); FX_GAP(13, st(3)); FX_GAP(14, st(4)); FX_GAP(15, st(5));
}
#undef FX_CHUNK
#undef FX_PACK
#undef FX_VRD
#undef FX_PV
#undef FX_GAP

template <int DQK, int ldq, int ldk, int ldv, int ldo>
__device__ __forceinline__ void attn_body_sp(const bf16_t* __restrict__ Qb, const bf16_t* __restrict__ Kh, const bf16_t* __restrict__ Vh,
                                             bf16_t* __restrict__ Ob, int seq, LAS unsigned char* lds, const bool usemax, const int nact = 8) {
    using C = Cfg<DQK>;
    constexpr int SHM_V = C::SHM_V, SHM_K = C::SHM_K, NKP = C::NKP, NR = DQK / 16 - C::QSP;
    int tid_ = threadIdx.x; asm volatile("" : "+v"(tid_));
    const int tid = tid_, wid = tid >> 6, lane = tid & 63, r32 = lane & 31, hi = lane >> 5;
    const bool act = __builtin_amdgcn_readfirstlane(wid) < nact;
    LAS unsigned char* V_lds = lds; LAS unsigned char* K_lds = lds + 2 * SHM_V;
    float m_reg = -1e30f, l_reg = 0; f32x16 o[4] = {}; bf16x8 qr[NR];
    const bf16_t* Qw = Qb + (long)(wid * QBLK + r32) * ldq + hi * 8;
    if (act) {
#pragma unroll
    for (int d0 = 0; d0 < NR; ++d0) qr[d0] = *(const bf16x8*)(Qw + d0 * 16);
    } else {
#pragma unroll
    for (int d0 = 0; d0 < NR; ++d0) qr[d0] = bf16x8{};
    }
    LAS unsigned char* qsp = lds + C::OFF_QSP + wid * (C::QSP * 1024) + lane * 16;
#pragma unroll
    for (int d0 = NR; d0 < DQK / 16; ++d0) *(LAS bf16x8*)(qsp + (d0 - NR) * 1024) = *(const bf16x8*)(Qw + d0 * 16);
    const int sr = tid >> 4, sc = (tid & 15) * 8, vst0 = v_st(sr, sc), vst1 = v_st(32 + sr, sc);
    const int krow = tid >> 3, kc16 = tid & 7;
    const int kstA = krow * C::KPITCH + ((kc16 * 16) ^ ((krow & 15) << 4)), kstB = krow * C::KPITCH + ((kc16 * 16 + 128) ^ ((krow & 15) << 4));
    const unsigned vb0 = (unsigned)(uintptr_t)V_lds + (unsigned)v_rd_base(lane);
    const __amdgpu_buffer_rsrc_t rsK = __builtin_amdgcn_make_buffer_rsrc((void*)Kh, (short)0, 0x7ffffff0, 0x00020000);
    const __amdgpu_buffer_rsrc_t rsV = __builtin_amdgcn_make_buffer_rsrc((void*)Vh, (short)0, 0x7ffffff0, 0x00020000);
    const int voffK = (krow * ldk + kc16 * 8) * 2, voffV = (sr * ldv + sc) * 2;
    u32x4 svs0, svs1, sks[NKP];
#define SLOAD1(k0) do { svs0 = __builtin_amdgcn_raw_buffer_load_b128(rsV, voffV, (k0) * (ldv * 2), 0); svs1 = __builtin_amdgcn_raw_buffer_load_b128(rsV, voffV, ((k0) + 32) * (ldv * 2), 0); \
    _Pragma("unroll") for (int _q = 0; _q < NKP; ++_q) sks[_q] = __builtin_amdgcn_raw_buffer_load_b128(rsK, voffK, (k0) * (ldk * 2) + _q * 128, 0); } while (0)
#define SWRITE1(b) do { *(LAS u32x4*)(V_lds + (b) * SHM_V + vst0) = svs0; *(LAS u32x4*)(V_lds + (b) * SHM_V + vst1) = svs1; \
    _Pragma("unroll") for (int _q = 0; _q < NKP; ++_q) *(LAS u32x4*)(K_lds + (b) * SHM_K + (_q == 1 ? kstB : kstA + (_q >> 1) * 256)) = sks[_q]; } while (0)
    const int NT = seq / KVBLK;
    SLOAD1(0); SWRITE1(0); SLOAD1(KVBLK); __syncthreads();
    if (ATT_PRIO && __builtin_amdgcn_readfirstlane(wid) >= 4) __builtin_amdgcn_s_setprio(1);
    if (usemax) {
#pragma unroll 2
    for (int j = 0; j < NT; ++j) {
        const int bsel = j & 1;
        if (act) {
        f32x16 p0, p1; float mn, al; bf16x8 pa0, pa1, pa2, pa3;
        qkt<DQK>(p0, p1, K_lds + bsel * SHM_K, qr, qsp, r32, hi);
        partialSM(p0, p1, m_reg, mn, al);
        if (__any(al < 1.f)) { int _t2 = threadIdx.x; asm volatile("" : "+v"(_t2));
            LAS float* _al = (LAS float*)(lds + 2 * SHM_V + 2 * SHM_K) + (_t2 >> 6) * 64 + 32; const int _r2 = _t2 & 31, _h2 = (_t2 >> 5) & 1;
            if (_h2 == 0) _al[_r2] = al; asm volatile("s_waitcnt lgkmcnt(0)" ::: "memory");
#pragma unroll
            for (int d = 0; d < 4; ++d)
#pragma unroll
                for (int r = 0; r < 16; ++r) o[d][r] *= _al[crow(r, _h2)]; }
        finishSM(p0, p1, al, l_reg, pa0, pa1, pa2, pa3); SBAR();
        pv_d0(o, vb0 + (unsigned)(bsel * SHM_V), pa0, pa1, pa2, pa3);
        }
        if (j + 1 < NT) { SWRITE1(bsel ^ 1); if (j + 2 < NT) SLOAD1((j + 2) * KVBLK); }
        __syncthreads();
    }
    } else if constexpr (DQK != 128 || !ATT_G2) {
#pragma unroll 2
    for (int j = 0; j < NT; ++j) {
        const int bsel = j & 1; const bool dw = j + 1 < NT, dl = j + 2 < NT;
        auto st = [&](int i) {
            if (dw) {
                if (i == 0) *(LAS u32x4*)(V_lds + (bsel ^ 1) * SHM_V + vst0) = svs0;
                if (i == 1) *(LAS u32x4*)(V_lds + (bsel ^ 1) * SHM_V + vst1) = svs1;
                if (i == 2) *(LAS u32x4*)(K_lds + (bsel ^ 1) * SHM_K + kstA) = sks[0];
                if (i == 3) *(LAS u32x4*)(K_lds + (bsel ^ 1) * SHM_K + kstB) = sks[1];
                if (i == 4 && NKP == 3) *(LAS u32x4*)(K_lds + (bsel ^ 1) * SHM_K + kstA + 256) = sks[NKP - 1];
            }
            if (i == 5 && dl) SLOAD1((j + 2) * KVBLK);
        };
        if (act) tile_fx<DQK>(o, l_reg, K_lds + bsel * SHM_K, vb0 + (unsigned)(bsel * SHM_V), qr, r32, hi, st);
        else { st(0); st(1); st(2); st(3); st(4); st(5); }
        __syncthreads();
    }
    } else {
    u32x4 svt0, svt1, skt[NKP];
#define SLOAD2(k0) do { svt0 = __builtin_amdgcn_raw_buffer_load_b128(rsV, voffV, (k0) * (ldv * 2), 0); svt1 = __builtin_amdgcn_raw_buffer_load_b128(rsV, voffV, ((k0) + 32) * (ldv * 2), 0); \
    _Pragma("unroll") for (int _q = 0; _q < NKP; ++_q) skt[_q] = __builtin_amdgcn_raw_buffer_load_b128(rsK, voffK, (k0) * (ldk * 2) + _q * 128, 0); } while (0)
#define SWRITE2(b) do { *(LAS u32x4*)(V_lds + (b) * SHM_V + vst0) = svt0; *(LAS u32x4*)(V_lds + (b) * SHM_V + vst1) = svt1; \
    _Pragma("unroll") for (int _q = 0; _q < NKP; ++_q) *(LAS u32x4*)(K_lds + (b) * SHM_K + (_q == 1 ? kstB : kstA + (_q >> 1) * 256)) = skt[_q]; } while (0)
    if (2 < NT) SLOAD2(2 * KVBLK);
    for (int j = 0; j < NT; j += 2) {
        if (act) tile_fx<DQK>(o, l_reg, K_lds, vb0, qr, r32, hi, [](int) {});
        SWRITE1(1); if (j + 3 < NT) SLOAD1((j + 3) * KVBLK);
        __syncthreads();
        if (act) tile_fx<DQK>(o, l_reg, K_lds + SHM_K, vb0 + (unsigned)SHM_V, qr, r32, hi, [](int) {});
        if (j + 2 < NT) { SWRITE2(0); if (j + 4 < NT) SLOAD2((j + 4) * KVBLK); }
        __syncthreads();
    }
#undef SLOAD2
#undef SWRITE2
    }
#undef SLOAD1
#undef SWRITE1
    if (ATT_PRIO) __builtin_amdgcn_s_setprio(0);
    if (act) {
        int t3 = threadIdx.x; asm volatile("" : "+v"(t3));
        const int wid3 = t3 >> 6, r3 = t3 & 31, h3 = (t3 >> 5) & 1, odd = t3 & 1;
        LAS float* li3 = (LAS float*)(lds + 2 * SHM_V + 2 * SHM_K) + wid3 * 64;
        if (h3 == 0) li3[r3] = l_reg; asm volatile("s_waitcnt lgkmcnt(0)" ::: "memory");
        float rli[16];
#pragma unroll
        for (int r = 0; r < 16; ++r) rli[r] = __builtin_amdgcn_rcpf(li3[crow(r, h3)]);
        bf16_t* Ow = Ob + (long)(wid3 * QBLK) * ldo + (r3 & ~1);
#pragma unroll
        for (int r = 0; r < 16; r += 2) {
#pragma unroll
            for (int d0 = 0; d0 < 4; ++d0) {
                const float a = o[d0][r] * rli[r], bq = o[d0][r + 1] * rli[r + 1];
                const float xs = odd ? a : bq;
                const float y = __uint_as_float((unsigned)__builtin_amdgcn_update_dpp(0, (int)__float_as_uint(xs), 0xB1, 0xF, 0xF, true));
                const int orow = odd ? crow(r + 1, h3) : crow(r, h3);
                const unsigned w = odd ? cvt_pk_bf16(y, bq) : cvt_pk_bf16(a, y);
                *(unsigned*)(Ow + (long)orow * ldo + d0 * 32) = w;
            }
        }
    }
}
template <int DQK, int ldq, int ldk, int ldv, int ldo>
__device__ __forceinline__ void attn_body_st(const bf16_t* __restrict__ Qb, const bf16_t* __restrict__ Kh, const bf16_t* __restrict__ Vh,
                                             bf16_t* __restrict__ Ob, int seq, LAS unsigned char* lds) {
    using C = Cfg<DQK>;
    constexpr int SHM_V = C::SHM_V, SHM_K = C::SHM_K, NKP = C::NKP, NR = DQK / 16, OFF_K = 3 * SHM_V, OFF_WS = 3 * SHM_V + 2 * SHM_K;
    int tid_ = threadIdx.x; asm volatile("" : "+v"(tid_));
    const int tid = tid_, wid = tid >> 6, lane = tid & 63, r32 = lane & 31, hi = lane >> 5;
    const bool lag = __builtin_amdgcn_readfirstlane(wid) >= 4;
    LAS unsigned char* V_lds = lds; LAS unsigned char* K_lds = lds + OFF_K;
    float m_reg = -1e30f, l_reg = 0; f32x16 o[4] = {}; bf16x8 qr[NR];
    const bf16_t* Qw = Qb + (long)(wid * QBLK + r32) * ldq + hi * 8;
#pragma unroll
    for (int d0 = 0; d0 < NR; ++d0) qr[d0] = *(const bf16x8*)(Qw + d0 * 16);
    const int sr = tid >> 4, sc = (tid & 15) * 8, vst0 = v_st(sr, sc), vst1 = v_st(32 + sr, sc);
    const int krow = tid >> 3, kc16 = tid & 7;
    const int kst = krow * (DQK * 2) + ((kc16 * 16) ^ ((krow & 7) << 4));
    const unsigned vb0 = (unsigned)(uintptr_t)V_lds + (unsigned)v_rd_base(lane);
    const __amdgpu_buffer_rsrc_t rsK = __builtin_amdgcn_make_buffer_rsrc((void*)Kh, (short)0, 0x7ffffff0, 0x00020000);
    const __amdgpu_buffer_rsrc_t rsV = __builtin_amdgcn_make_buffer_rsrc((void*)Vh, (short)0, 0x7ffffff0, 0x00020000);
    const int voffK = (krow * ldk + kc16 * 8) * 2, voffV = (sr * ldv + sc) * 2;
    u32x4 svs0, svs1, sks[NKP];
#define SLOAD1(k0) do { svs0 = __builtin_amdgcn_raw_buffer_load_b128(rsV, voffV, (k0) * (ldv * 2), 0); svs1 = __builtin_amdgcn_raw_buffer_load_b128(rsV, voffV, ((k0) + 32) * (ldv * 2), 0); \
    _Pragma("unroll") for (int _q = 0; _q < NKP; ++_q) sks[_q] = __builtin_amdgcn_raw_buffer_load_b128(rsK, voffK, (k0) * (ldk * 2) + _q * 128, 0); } while (0)
#define SWRITE2(kb, vbuf) do { *(LAS u32x4*)(V_lds + (vbuf) * SHM_V + vst0) = svs0; *(LAS u32x4*)(V_lds + (vbuf) * SHM_V + vst1) = svs1; \
    _Pragma("unroll") for (int _q = 0; _q < NKP; ++_q) *(LAS u32x4*)(K_lds + (kb) * SHM_K + kst + _q * 128) = sks[_q]; } while (0)
    const int NT = seq / KVBLK;
    SLOAD1(0); SWRITE2(0, 0); SLOAD1(KVBLK); __syncthreads();
    bf16x8 pa0 = {}, pa1 = {}, pa2 = {}, pa3 = {};
    int vcur = 0, vprev = 0;
    for (int j = 0; j < NT; ++j) {
        const int kb = j & 1;
        if (lag && j > 0) pv_d0(o, vb0 + (unsigned)(vprev * SHM_V), pa0, pa1, pa2, pa3);
        f32x16 p0, p1; float mn, al;
        qkt<DQK>(p0, p1, K_lds + kb * SHM_K, qr, K_lds, r32, hi);
        partialSM(p0, p1, m_reg, mn, al);
        if (__any(al < 1.f)) { int _t2 = threadIdx.x; asm volatile("" : "+v"(_t2));
            LAS float* _al = (LAS float*)(lds + OFF_WS) + (_t2 >> 6) * 64 + 32; const int _r2 = _t2 & 31, _h2 = (_t2 >> 5) & 1;
            if (_h2 == 0) _al[_r2] = al; asm volatile("s_waitcnt lgkmcnt(0)" ::: "memory");
#pragma unroll
            for (int d = 0; d < 4; ++d)
#pragma unroll
                for (int r = 0; r < 16; ++r) o[d][r] *= _al[crow(r, _h2)]; }
        finishSM(p0, p1, al, l_reg, pa0, pa1, pa2, pa3); SBAR();
        if (!lag) pv_d0(o, vb0 + (unsigned)(vcur * SHM_V), pa0, pa1, pa2, pa3);
        const int vnext = (vcur == 2) ? 0 : vcur + 1;
        if (j + 1 < NT) { SWRITE2(kb ^ 1, vnext); if (j + 2 < NT) SLOAD1((j + 2) * KVBLK); }
        __syncthreads();
        vprev = vcur; vcur = vnext;
    }
    if (lag) pv_d0(o, vb0 + (unsigned)(vprev * SHM_V), pa0, pa1, pa2, pa3);
#undef SLOAD1
#undef SWRITE2
    {
        int t3 = threadIdx.x; asm volatile("" : "+v"(t3));
        const int wid3 = t3 >> 6, r3 = t3 & 31, h3 = (t3 >> 5) & 1, odd = t3 & 1;
        LAS float* li3 = (LAS float*)(lds + OFF_WS) + wid3 * 64;
        if (h3 == 0) li3[r3] = l_reg; asm volatile("s_waitcnt lgkmcnt(0)" ::: "memory");
        float rli[16];
#pragma unroll
        for (int r = 0; r < 16; ++r) rli[r] = __builtin_amdgcn_rcpf(li3[crow(r, h3)]);
        bf16_t* Ow = Ob + (long)(wid3 * QBLK) * ldo + (r3 & ~1);
#pragma unroll
        for (int r = 0; r < 16; r += 2) {
#pragma unroll
            for (int d0 = 0; d0 < 4; ++d0) {
                const float a = o[d0][r] * rli[r], bq = o[d0][r + 1] * rli[r + 1];
                const float xs = odd ? a : bq;
                const float y = __uint_as_float((unsigned)__builtin_amdgcn_update_dpp(0, (int)__float_as_uint(xs), 0xB1, 0xF, 0xF, true));
                const int orow = odd ? crow(r + 1, h3) : crow(r, h3);
                const unsigned w = odd ? cvt_pk_bf16(y, bq) : cvt_pk_bf16(a, y);
                *(unsigned*)(Ow + (long)orow * ldo + d0 * 32) = w;
            }
        }
    }
}
}
namespace ml {
constexpr int PQ = 136;
constexpr int PS = 72;
constexpr int OFF_CH = 4 * 2304 * 4, OFF_Q = OFF_CH + 1024, OFF_K = OFF_Q + 64 * PQ * 2, OFF_V = OFF_K + 64 * PQ * 2, OFF_CT = OFF_V + 64 * PQ * 2, OFF_QK = OFF_CT + 128 * PQ * 2,
              OFF_N = OFF_QK + 64 * PS * 2, OFF_KP = OFF_N + 512, OFF_QN = OFF_KP + 2048, OFF_PS = OFF_QN + 256, LDS_END = OFF_PS + 1024;
static_assert(LDS_END <= LDS_MISC, "mLSTM LDS map");

__device__ __forceinline__ f32x4 mma16(bf16x8 a, bf16x8 b, f32x4 c) { return __builtin_amdgcn_mfma_f32_16x16x32_bf16(a, b, c, 0, 0, 0); }

__device__ __forceinline__ void mlstm_seq(LAS unsigned char* lds, const bf16_t* __restrict__ P, const float* __restrict__ gi, const float* __restrict__ gf, bf16_t* __restrict__ HOUT,
                                          int b, int h, int dir, bool ctx_out) {
    int tid_ = threadIdx.x; asm volatile("" : "+v"(tid_));
    const int tid = tid_, lane = tid & 63, wid = __builtin_amdgcn_readfirstlane(tid >> 6), fr = lane & 15, fq = lane >> 4;
    LAS float* colfac = (LAS float*)lds; LAS float* rowfac = colfac + 2304; LAS float* winter = rowfac + 2304; LAS float* floorv = winter + 2304;
    LAS float* chs = (LAS float*)(lds + OFF_CH);
    LAS bf16_t* Qs = (LAS bf16_t*)(lds + OFF_Q); LAS bf16_t* Ks = (LAS bf16_t*)(lds + OFF_K); LAS bf16_t* Vs = (LAS bf16_t*)(lds + OFF_V);
    LAS bf16_t* Ct = (LAS bf16_t*)(lds + OFF_CT); LAS bf16_t* QKs = (LAS bf16_t*)(lds + OFF_QK);
    LAS float* nvec = (LAS float*)(lds + OFF_N); LAS float* kpart = (LAS float*)(lds + OFF_KP); LAS float* qn = (LAS float*)(lds + OFF_QN); LAS float* psum = (LAS float*)(lds + OFF_PS);

    for (int c = wid; c < 36; c += 8) {
        const int cid = dir ? (c < 4 ? 3 - c : 39 - c) : c;
        const int loc = dir ? 63 - lane : lane;
        const float li = gi[cid * 64 + loc], lf = gf[cid * 64 + loc];
        float bc = lf;
#pragma unroll
        for (int o = 1; o < 64; o <<= 1) { const float t = __shfl_up(bc, o); if (lane >= o) bc += t; }
        const float u = li - bc;
        float pm = u;
#pragma unroll
        for (int o = 1; o < 64; o <<= 1) { const float t = __shfl_up(pm, o); if (lane >= o) pm = fmaxf(pm, t); }
        const float mloc = __shfl(pm, 63), btot = __shfl(bc, 63);
        const int idx = c * 64 + loc;
        colfac[idx] = u; rowfac[idx] = pm; floorv[idx] = bc;
        if (lane == 0) { chs[c] = mloc; chs[36 + c] = btot; }
    }
    __syncthreads();
    if (tid == 0) {
        float m = 0.f;
        for (int c = 0; c < 36; ++c) { const float mloc = chs[c], btot = chs[36 + c], mm = fmaxf(m, mloc);
            chs[72 + c] = m; chs[108 + c] = __expf(m - mm); chs[144 + c] = __expf(mloc - mm); m = btot + mm; }
    }
    __syncthreads();
    for (int i = tid; i < 2304; i += 512) {
        const int c = i >> 6; const float m = chs[72 + c], mloc = chs[c], u = colfac[i], pm = rowfac[i], bc = floorv[i], mx = fmaxf(m, pm);
        colfac[i] = __expf(u - mloc); rowfac[i] = __expf(mloc - mx); winter[i] = __expf(m - mx); floorv[i] = __expf(-bc - mx);
    }
    for (int i = tid; i < 128 * PQ / 2; i += 512) ((LAS unsigned*)Ct)[i] = 0u;
    if (tid < 128) nvec[tid] = 0.f;
    f32x4 Cacc[8];
#pragma unroll
    for (int e = 0; e < 8; ++e) Cacc[e] = (f32x4){0.f, 0.f, 0.f, 0.f};

    const int prr = tid >> 4, pcs = tid & 15;
    u32x4 pre[6];
#define ML_LOAD(cc) do { const int _cid = dir ? ((cc) < 4 ? 3 - (cc) : 39 - (cc)) : (cc); const bf16_t* _base = P + (size_t)(b * TPB + _cid * 64) * NPW + h * 128 + pcs * 8; \
    _Pragma("unroll") for (int _i = 0; _i < 6; ++_i) pre[_i] = *(const u32x4*)(_base + (size_t)(prr + (_i & 1) * 32) * NPW + (_i >> 1) * 512); } while (0)
    ML_LOAD(0);
    const int q4 = (lane & 15) >> 2, p4 = lane & 3;
    const unsigned vs_addr = (unsigned)(uintptr_t)Vs, ks_addr = (unsigned)(uintptr_t)Ks;
    const unsigned trb = (unsigned)(((8 * fq + q4) * PQ + 4 * p4) * 2);
    for (int c = 0; c < 36; ++c) {
        const int cid = dir ? (c < 4 ? 3 - c : 39 - c) : c;
        const int cb = c * 64;
        {
            const float cf0 = colfac[cb + prr], cf1 = colfac[cb + prr + 32];
#pragma unroll
            for (int i = 0; i < 6; ++i) {
                const int rr = prr + (i & 1) * 32; u32x4 w = pre[i];
                if ((i >> 1) == 1) { float f[8]; unpack8(w, f); const float cf = (i & 1) ? cf1 : cf0;
#pragma unroll
                    for (int j = 0; j < 8; ++j) f[j] *= cf;
                    w = pack8(f); }
                LAS bf16_t* dst = ((i >> 1) == 0 ? Qs : (i >> 1) == 1 ? Ks : Vs) + rr * PQ + pcs * 8;
                *(LAS u32x4*)dst = w;
            }
        }
        __syncthreads();
        if (c + 1 < 36) ML_LOAD(c + 1);
        {
            const int sb = wid >> 1, tbase = (wid & 1) * 2;
            bf16x8 ka[4];
#pragma unroll
            for (int ks = 0; ks < 4; ++ks) ka[ks] = *(const LAS bf16x8*)(Ks + (16 * sb + fr) * PQ + ks * 32 + fq * 8);
#pragma unroll
            for (int tt = 0; tt < 2; ++tt) {
                const int tb = tbase + tt; f32x4 acc = (f32x4){0.f, 0.f, 0.f, 0.f};
#pragma unroll
                for (int ks = 0; ks < 4; ++ks) { const bf16x8 qb = *(const LAS bf16x8*)(Qs + (16 * tb + fr) * PQ + ks * 32 + fq * 8); acc = mma16(ka[ks], qb, acc); }
                const int t = 16 * tb + fr, s0 = 16 * sb + 4 * fq; const float rf = rowfac[cb + t];
                float v[4];
#pragma unroll
                for (int i = 0; i < 4; ++i) { const int s = s0 + i; const bool ok = dir ? (s >= t) : (s <= t); v[i] = ok ? acc[i] * rf : 0.f; }
                u32x2 w; w.x = cvt_pk_bf16(v[0], v[1]); w.y = cvt_pk_bf16(v[2], v[3]);
                *(LAS u32x2*)(QKs + t * PS + s0) = w;
                float ps = (v[0] + v[1]) + (v[2] + v[3]); ps += __shfl_xor(ps, 16); ps += __shfl_xor(ps, 32);
                if (fq == 0) psum[sb * 64 + t] = ps;
            }
            { const int t = tid >> 3, part = tid & 7; float s = 0.f;
#pragma unroll
              for (int j = 0; j < 16; ++j) s += __uint_as_float(((unsigned)Qs[t * PQ + part * 16 + j]) << 16) * nvec[part * 16 + j];
              s += __shfl_xor(s, 1); s += __shfl_xor(s, 2); s += __shfl_xor(s, 4);
              if (part == 0) qn[t] = s; }
            { const int d = tid & 127, qq = tid >> 7; float s = 0.f;
#pragma unroll
              for (int j = 0; j < 16; ++j) s += __uint_as_float(((unsigned)Ks[(qq * 16 + j) * PQ + d]) << 16);
              kpart[qq * 128 + d] = s; }
        }
        __syncthreads();
        const float wc = chs[108 + c], sc2 = chs[144 + c];
        {
            const int tb = wid >> 1, eb0 = (wid & 1) * 4;
            f32x4 nacc[4];
#pragma unroll
            for (int j = 0; j < 4; ++j) nacc[j] = (f32x4){0.f, 0.f, 0.f, 0.f};
            bf16x8 qa[4];
#pragma unroll
            for (int ks = 0; ks < 4; ++ks) qa[ks] = *(const LAS bf16x8*)(Qs + (16 * tb + fr) * PQ + ks * 32 + fq * 8);
#pragma unroll
            for (int j = 0; j < 4; ++j)
#pragma unroll
                for (int ks = 0; ks < 4; ++ks) { const bf16x8 cbv = *(const LAS bf16x8*)(Ct + (16 * (eb0 + j) + fr) * PQ + ks * 32 + fq * 8); nacc[j] = mma16(qa[ks], cbv, nacc[j]); }
            float wi[4], inv[4];
#pragma unroll
            for (int i = 0; i < 4; ++i) wi[i] = winter[cb + 16 * tb + 4 * fq + i];
#pragma unroll
            for (int j = 0; j < 4; ++j)
#pragma unroll
                for (int i = 0; i < 4; ++i) nacc[j][i] *= wi[i];
            bf16x8 pa[2];
#pragma unroll
            for (int ks = 0; ks < 2; ++ks) pa[ks] = *(const LAS bf16x8*)(QKs + (16 * tb + fr) * PS + ks * 32 + fq * 8);
            const unsigned vb = vs_addr + trb + (unsigned)(eb0 * 32);
            s16x4 vl[4][2], vh[4][2];
#define ML_TRV(J, KS) vl[J][KS] = tr_read<(KS) * 32 * PQ * 2 + (J) * 32>(vb); vh[J][KS] = tr_read<(KS) * 32 * PQ * 2 + (J) * 32 + 4 * PQ * 2>(vb);
            ML_TRV(0, 0) ML_TRV(0, 1) ML_TRV(1, 0) ML_TRV(1, 1) ML_TRV(2, 0) ML_TRV(2, 1) ML_TRV(3, 0) ML_TRV(3, 1)
#undef ML_TRV
            LGKM0();
#pragma unroll
            for (int j = 0; j < 4; ++j)
#pragma unroll
                for (int ks = 0; ks < 2; ++ks) nacc[j] = mma16(pa[ks], PK8(vl[j][ks], vh[j][ks]), nacc[j]);
#pragma unroll
            for (int i = 0; i < 4; ++i) { const int t = 16 * tb + 4 * fq + i;
                const float den = wi[i] * qn[t] + ((psum[t] + psum[64 + t]) + (psum[128 + t] + psum[192 + t]));
                inv[i] = 1.0f / fmaxf(fabsf(den), floorv[cb + t]); }
            if (ctx_out || cid >= 4) {
                bf16_t* hb = HOUT + (size_t)(b * TPB + cid * 64 + 16 * tb + 4 * fq) * 512 + h * 128 + 16 * eb0 + fr;
#pragma unroll
                for (int j = 0; j < 4; ++j)
#pragma unroll
                    for (int i = 0; i < 4; ++i) { const float hv = nacc[j][i] * inv[i]; hb[(size_t)i * 512 + j * 16] = (bf16_t)(cvt_pk_bf16(hv, hv) & 0xffffu); }
            }
        }
        {
            const unsigned kb = ks_addr + trb + (unsigned)(wid * 32);
            const s16x4 al0 = tr_read<0>(kb), ah0 = tr_read<4 * PQ * 2>(kb), al1 = tr_read<32 * PQ * 2>(kb), ah1 = tr_read<32 * PQ * 2 + 4 * PQ * 2>(kb);
            const unsigned vb = vs_addr + trb;
            s16x4 vl[8][2], vh[8][2];
#define ML_TRV(E, KS) vl[E][KS] = tr_read<(KS) * 32 * PQ * 2 + (E) * 32>(vb); vh[E][KS] = tr_read<(KS) * 32 * PQ * 2 + (E) * 32 + 4 * PQ * 2>(vb);
            ML_TRV(0, 0) ML_TRV(0, 1) ML_TRV(1, 0) ML_TRV(1, 1) ML_TRV(2, 0) ML_TRV(2, 1) ML_TRV(3, 0) ML_TRV(3, 1)
            ML_TRV(4, 0) ML_TRV(4, 1) ML_TRV(5, 0) ML_TRV(5, 1) ML_TRV(6, 0) ML_TRV(6, 1) ML_TRV(7, 0) ML_TRV(7, 1)
#undef ML_TRV
            LGKM0();
            const bf16x8 a0 = PK8(al0, ah0), a1 = PK8(al1, ah1);
#pragma unroll
            for (int e = 0; e < 8; ++e) { f32x4 t4 = (f32x4){0.f, 0.f, 0.f, 0.f};
                t4 = mma16(a0, PK8(vl[e][0], vh[e][0]), t4); t4 = mma16(a1, PK8(vl[e][1], vh[e][1]), t4);
                Cacc[e] = Cacc[e] * wc + t4 * sc2; }
        }
        __syncthreads();
#pragma unroll
        for (int e = 0; e < 8; ++e) { u32x2 w; w.x = cvt_pk_bf16(Cacc[e][0], Cacc[e][1]); w.y = cvt_pk_bf16(Cacc[e][2], Cacc[e][3]);
            *(LAS u32x2*)(Ct + (16 * e + fr) * PQ + 16 * wid + 4 * fq) = w; }
        if (tid < 128) nvec[tid] = wc * nvec[tid] + sc2 * ((kpart[tid] + kpart[128 + tid]) + (kpart[256 + tid] + kpart[384 + tid]));
    }
    __syncthreads();
#undef ML_LOAD
}
}
struct TileOrder {
    int G, c, nM, nN, total, latonly;
    __device__ void init(int nM_, int nN_, int G_, int c_, int latonly_) { nM = nM_; nN = nN_; G = G_; c = c_; total = nM_ * nN_; latonly = latonly_; }
    __device__ bool next(int i, pg8::Unit& u) const {
        const int L = i * G + c; if (L >= total) return false;
        const int gid = L / (8 * nN), rem = L % (8 * nN); int pmi = gid * 8 + (rem & 7); const int pni = rem >> 3;
        if (latonly) pmi = (pmi >> 3) * 9 + 1 + (pmi & 7);
        u.pm = pmi; u.pn = pni; return true;
    }
    __device__ __forceinline__ void a_ready(const pg8::Unit&) const {}
    __device__ __forceinline__ void done(const pg8::Unit&) const {}
};
struct InProjLastOrder {
    int G, c;
    __device__ void init(int G_, int c_) { G = G_; c = c_; }
    __device__ bool next(int i, pg8::Unit& u) const {
        const int L = i * G + c; if (L >= 1216) return false;
        if (L < 1152) { const int gid = L / 144, rem = L % 144, pmi = gid * 8 + (rem & 7); u.pm = (pmi >> 3) * 9 + 1 + (pmi & 7); u.pn = rem >> 3; }
        else { const int j = L - 1152, ci = j >> 3; u.pm = 9 * (j & 7); u.pn = ci < 4 ? 2 + ci : ci < 6 ? 8 + ci : 10 + ci; }
        return true;
    }
    __device__ __forceinline__ void a_ready(const pg8::Unit&) const {}
    __device__ __forceinline__ void done(const pg8::Unit&) const {}
};
struct MoeOrder {
    int G, c, RT, NJ, total;
    __device__ void init(int RT_, int NJ_, int G_, int c_) { RT = RT_; NJ = NJ_; G = G_; c = c_; total = NEXP * RT_ * NJ_; }
    __device__ bool next(int i, pg8::Unit& u) const {
        const int L = i * G + c; if (L >= total) return false;
        const int e = L / (RT * NJ), rem = L % (RT * NJ);
        int ii, j; if (MOE_ORDER_ALT) { const int jb = rem / (RT * 4), r2 = rem % (RT * 4); j = jb * 4 + (r2 & 3); ii = r2 >> 2; } else { ii = rem % RT; j = rem / RT; }
        u.pm = e * RT + ii; u.pn = e * NJ + j; return true;
    }
    __device__ __forceinline__ void a_ready(const pg8::Unit&) const {}
    __device__ __forceinline__ void done(const pg8::Unit&) const {}
};
typedef const f32x4 (&AccRef)[2][2][4][2];
struct EpiInProj {
    static constexpr bool PERM = true, AFTER_DRAIN = false;
    bf16_t* P; float* PG;
    __device__ __forceinline__ void operator()(AccRef acc, const pg8::Unit& u, int wr, int wc, int fr, int fq) const {
        const int row0 = u.pm * 256 + wr * 64 + fr;
        if (u.pn < 17) {
            const int col0 = u.pn * 256 + wc * 32 + 8 * fq;
#pragma unroll
            for (int ai = 0; ai < 2; ++ai)
#pragma unroll
                for (int m = 0; m < 4; ++m) { bf16_t* rowp = P + (size_t)(row0 + ai * 128 + m * 16) * NPW + col0;
#pragma unroll
                    for (int bj = 0; bj < 2; ++bj) { const f32x4 v0 = acc[ai][bj][m][0], v1 = acc[ai][bj][m][1];
                        u32x4 w; w.x = cvt_pk_bf16(v0[0], v0[1]); w.y = cvt_pk_bf16(v0[2], v0[3]); w.z = cvt_pk_bf16(v1[0], v1[1]); w.w = cvt_pk_bf16(v1[2], v1[3]);
                        *(u32x4*)(rowp + bj * 128) = w; } }
        } else {
            const int col0 = wc * 32 + 8 * fq;
#pragma unroll
            for (int ai = 0; ai < 2; ++ai)
#pragma unroll
                for (int m = 0; m < 4; ++m) { float* rowp = PG + (size_t)(row0 + ai * 128 + m * 16) * 128 + col0;
                    *(f32x4*)(rowp) = acc[ai][0][m][0]; *(f32x4*)(rowp + 4) = acc[ai][0][m][1]; }
        }
    }
};
struct EpiBf16Store {
    static constexpr bool PERM = true, AFTER_DRAIN = false;
    bf16_t* O; int ldc;
    __device__ __forceinline__ void operator()(AccRef acc, const pg8::Unit& u, int wr, int wc, int fr, int fq) const {
        const int row0 = u.pm * 256 + wr * 64 + fr, col0 = u.pn * 256 + wc * 32 + 8 * fq;
#pragma unroll
        for (int ai = 0; ai < 2; ++ai)
#pragma unroll
            for (int m = 0; m < 4; ++m) { bf16_t* rowp = O + (size_t)(row0 + ai * 128 + m * 16) * ldc + col0;
#pragma unroll
                for (int bj = 0; bj < 2; ++bj) { const f32x4 v0 = acc[ai][bj][m][0], v1 = acc[ai][bj][m][1];
                    u32x4 w; w.x = cvt_pk_bf16(v0[0], v0[1]); w.y = cvt_pk_bf16(v0[2], v0[3]); w.z = cvt_pk_bf16(v1[0], v1[1]); w.w = cvt_pk_bf16(v1[2], v1[3]);
                    *(u32x4*)(rowp + bj * 128) = w; } }
    }
};
struct EpiOutProj {
    static constexpr bool PERM = false, AFTER_DRAIN = false;
    float* X; const float* g1;
    const float* xin; const float* cin;
    __device__ __forceinline__ void operator()(AccRef acc, const pg8::Unit& u, int wr, int wc, int fr, int fq) const {
        const int row0 = u.pm * 256 + wr * 64 + fr, col0 = u.pn * 256 + wc * 32 + 4 * fq;
        const int bb = u.pm / 9, ti = u.pm % 9, mr = (ti == 0) ? 8 : bb;
        const float* g = g1 + (size_t)mr * 12288 + col0;
        const float* src = xin ? (ti == 0 ? cin + ((size_t)bb * 256 + wr * 64 + fr) * DM : xin + ((size_t)bb * 2048 + (ti - 1) * 256 + wr * 64 + fr) * DM) + col0
                               : X + (size_t)row0 * DM + col0;
        f32x4 gv[2][2];
#pragma unroll
        for (int bj = 0; bj < 2; ++bj)
#pragma unroll
            for (int n = 0; n < 2; ++n) gv[bj][n] = *(const f32x4*)(g + bj * 128 + n * 16);
#pragma unroll
        for (int ai = 0; ai < 2; ++ai)
#pragma unroll
            for (int m = 0; m < 4; ++m) { float* rowp = X + (size_t)(row0 + ai * 128 + m * 16) * DM + col0; const float* sp = src + (size_t)(ai * 128 + m * 16) * DM;
#pragma unroll
                for (int bj = 0; bj < 2; ++bj)
#pragma unroll
                    for (int n = 0; n < 2; ++n) { f32x4 xv = *(const f32x4*)(sp + bj * 128 + n * 16); xv += gv[bj][n] * acc[ai][bj][m][n]; *(f32x4*)(rowp + bj * 128 + n * 16) = xv; } }
    }
};
struct EpiSwiGLU {
    static constexpr bool PERM = true, AFTER_DRAIN = false;
    bf16_t* ACT; int NJ;
    __device__ __forceinline__ void operator()(AccRef acc, const pg8::Unit& u, int wr, int wc, int fr, int fq) const {
        const int row0 = u.pm * 256 + wr * 64 + fr, j = u.pn % NJ, col0 = j * 128 + wc * 32 + 8 * fq;
#pragma unroll
        for (int ai = 0; ai < 2; ++ai)
#pragma unroll
            for (int m = 0; m < 4; ++m) { bf16_t* rowp = ACT + (size_t)(row0 + ai * 128 + m * 16) * 2048 + col0;
                float a[8];
#pragma unroll
                for (int n = 0; n < 2; ++n)
#pragma unroll
                    for (int q = 0; q < 4; ++q) { const float gt = acc[ai][0][m][n][q], up = acc[ai][1][m][n][q];
                        a[n * 4 + q] = gt * __builtin_amdgcn_rcpf(1.0f + __expf(-gt)) * up; }
                *(u32x4*)rowp = pack8(a); }
    }
};
struct EpiDown {
    static constexpr bool PERM = true, AFTER_DRAIN = false;
    bf16_t* Y; const float* gv; int NJ;
    __device__ __forceinline__ void operator()(AccRef acc, const pg8::Unit& u, int wr, int wc, int fr, int fq) const {
        const int row0 = u.pm * 256 + wr * 64 + fr, j = u.pn % NJ, col0 = j * 256 + wc * 32 + 8 * fq;
#pragma unroll
        for (int ai = 0; ai < 2; ++ai)
#pragma unroll
            for (int m = 0; m < 4; ++m) { const int row = row0 + ai * 128 + m * 16; const float g = gv[row]; bf16_t* rowp = Y + (size_t)row * 2048 + col0;
#pragma unroll
                for (int bj = 0; bj < 2; ++bj) { const f32x4 v0 = acc[ai][bj][m][0] * g, v1 = acc[ai][bj][m][1] * g;
                    u32x4 w; w.x = cvt_pk_bf16(v0[0], v0[1]); w.y = cvt_pk_bf16(v0[2], v0[3]); w.z = cvt_pk_bf16(v1[0], v1[1]); w.w = cvt_pk_bf16(v1[2], v1[3]);
                    *(u32x4*)(rowp + bj * 128) = w; } }
    }
};

struct Frame {
    LAS unsigned char* lds; __attribute__((address_space(1))) unsigned char* ws; int tid, lane, wid, bid, G, vcu;
    __device__ __forceinline__ float* MOD() const { return (float*)(ws + WS_MOD); }
    __device__ __forceinline__ float* ROPEG() const { return (float*)(ws + WS_ROPEG); }
    __device__ __forceinline__ float* ROPEM() const { return (float*)(ws + WS_ROPEM); }
    __device__ __forceinline__ float* GI() const { return (float*)(ws + WS_GI); }
    __device__ __forceinline__ float* GF() const { return (float*)(ws + WS_GF); }
    __device__ __forceinline__ float* AFF() const { return (float*)(ws + WS_AFF); }
    __device__ __forceinline__ int* PTOK() const { return (int*)(ws + WS_PTOK); }
    __device__ __forceinline__ float* PGV() const { return (float*)(ws + WS_PGV); }
    __device__ __forceinline__ int* TOKSLOT() const { return (int*)(ws + WS_TOKSLOT); }
    __device__ __forceinline__ bf16_t* WIN() const { return (bf16_t*)(ws + WS_WIN); }
    __device__ __forceinline__ bf16_t* WOUT() const { return (bf16_t*)(ws + WS_WOUT); }
    __device__ __forceinline__ bf16_t* WUQ() const { return (bf16_t*)(ws + WS_WUQ); }
    __device__ __forceinline__ bf16_t* WUKV() const { return (bf16_t*)(ws + WS_WUKV); }
    __device__ __forceinline__ bf16_t* WGU() const { return (bf16_t*)(ws + WS_WGU); }
    __device__ __forceinline__ bf16_t* WD() const { return (bf16_t*)(ws + WS_WD); }
    __device__ __forceinline__ float* X() const { return (float*)(ws + WS_X); }
    __device__ __forceinline__ bf16_t* H() const { return (bf16_t*)(ws + WS_H); }
    __device__ __forceinline__ bf16_t* P() const { return (bf16_t*)(ws + WS_P); }
    __device__ __forceinline__ float* PG() const { return (float*)(ws + WS_PG); }
    __device__ __forceinline__ bf16_t* QG() const { return (bf16_t*)(ws + WS_QG); }
    __device__ __forceinline__ bf16_t* KG() const { return (bf16_t*)(ws + WS_KG); }
    __device__ __forceinline__ bf16_t* QA() const { return (bf16_t*)(ws + WS_QA); }
    __device__ __forceinline__ bf16_t* KVA() const { return (bf16_t*)(ws + WS_KVA); }
    __device__ __forceinline__ bf16_t* MQ() const { return (bf16_t*)(ws + WS_MQ); }
    __device__ __forceinline__ bf16_t* MKV() const { return (bf16_t*)(ws + WS_MKV); }
    __device__ __forceinline__ bf16_t* QM() const { return (bf16_t*)(ws + WS_QM); }
    __device__ __forceinline__ bf16_t* KM() const { return (bf16_t*)(ws + WS_KM); }
    __device__ __forceinline__ float* HF() const { return (float*)(ws + WS_HF); }
    __device__ __forceinline__ float* HB() const { return (float*)(ws + WS_HB); }
    __device__ __forceinline__ bf16_t* MIX() const { return (bf16_t*)(ws + WS_MIX); }
    __device__ __forceinline__ bf16_t* XG() const { return (bf16_t*)(ws + WS_XG); }
    __device__ __forceinline__ bf16_t* ACT() const { return (bf16_t*)(ws + WS_ACT); }
    __device__ __forceinline__ bf16_t* Y() const { return (bf16_t*)(ws + WS_Y); }
    __device__ __forceinline__ unsigned* ctl() const { return (unsigned*)(ws + WS_CTL); }
};
__device__ __forceinline__ Frame fresh(const Frame& F0) {
    Frame F = F0; int t = threadIdx.x; asm volatile("" : "+v"(t)); F.tid = t; F.lane = t & 63; F.wid = __builtin_amdgcn_readfirstlane(t >> 6);
    __attribute__((address_space(1))) unsigned char* w = F0.ws; asm volatile("" : "+s"(w)); F.ws = w; return F;
}

constexpr int CVT_SPL = 1668, CVT_NS = 2 * CVT_SPL;
struct CvtStrip { const float* sp; bf16_t* dq; int ld, K, nk; float sc; };
__device__ __forceinline__ CvtStrip cvt_strip(const Params& p, const Frame& F, int s) {
    const int c4 = (F.tid & 15) * 4, r4 = (F.tid >> 4) * 4, nl = F.tid >> 3, seg = F.tid & 7;
    const int l = s / CVT_SPL; int v = s % CVT_SPL;
    const float* src; bf16_t* dst; int ld, K, col; float scl = 1.f;
    if (v < 72) { K = 2048; src = p.w_in + (size_t)l * 2048 * 4432; ld = 4432; dst = F.WIN() + ((size_t)l * NPW + v * 64) * 2048;
        const int n = v * 64 + c4; col = n < 2048 ? n : n < 4352 ? n + 16 : n < 4368 ? n - 2304 : n < 4432 ? n : -1;
        if (col >= 512 && col < 1024) scl = 0.08838834764831845f; }
    else if (v < 104) { v -= 72; K = 2048; src = p.w_out + (size_t)l * 2048 * 2048; ld = 2048; dst = F.WOUT() + ((size_t)l * 2048 + v * 64) * 2048; col = v * 64 + c4; }
    else if (v < 116) { v -= 104; K = 512; src = p.mla_w_uq + (size_t)l * 512 * 768; ld = 768; dst = F.WUQ() + ((size_t)l * 768 + v * 64) * 512; col = v * 64 + c4; }
    else if (v < 132) { v -= 116; K = 256; src = p.mla_w_ukv + (size_t)l * 256 * 1024; ld = 1024; dst = F.WUKV() + ((size_t)l * 1024 + v * 64) * 256; col = v * 64 + c4; }
    else if (v < 1156) { v -= 132; K = 2048; const int e = v >> 6, rr = (v & 63) * 64, bj = (rr >> 7) & 1;
        src = (bj ? p.w_up : p.w_gate) + (size_t)(l * 16 + e) * 2048 * 2048; ld = 2048; dst = F.WGU() + ((size_t)(l * 16 + e) * 4096 + rr) * 2048; col = (rr >> 8) * 128 + (rr & 127) + c4; }
    else { v -= 1156; K = 2048; const int e = v >> 5, rr = (v & 31) * 64;
        src = p.w_down + (size_t)(l * 16 + e) * 2048 * 2048; ld = 2048; dst = F.WD() + ((size_t)(l * 16 + e) * 2048 + rr) * 2048; col = rr + c4; }
    CvtStrip d; d.sp = src + (size_t)r4 * ld + (col >= 0 ? col : 0); d.dq = dst + (size_t)nl * K + seg * 16; d.ld = ld; d.K = K; d.nk = K >> 7; d.sc = col >= 0 ? scl : 0.f; return d;
}
__device__ __forceinline__ void cvt_issue(const CvtStrip& d, int kt, f32x4 (&v)[4]) {
    const float* q = d.sp + (size_t)(kt * 128) * d.ld;
#pragma unroll
    for (int i = 0; i < 4; ++i) v[i] = CVT_NT_LOADS ? __builtin_nontemporal_load((const f32x4*)(q + (size_t)i * d.ld)) : *(const f32x4*)(q + (size_t)i * d.ld);
}
constexpr int CVT_PB = 264, CVT_TB = 64 * CVT_PB;
__device__ __forceinline__ void cvt_finish(const Frame& F, const CvtStrip& d, int kt, const f32x4 (&v)[4], LAS unsigned char* T) {
    const int tid = F.tid; const float sc = d.sc;
    LAS unsigned char* wp = T + ((tid & 15) * 4) * CVT_PB + (tid >> 4) * 8;
#pragma unroll
    for (int q = 0; q < 4; ++q) { u32x2 w; w.x = cvt_pk_bf16(v[0][q] * sc, v[1][q] * sc); w.y = cvt_pk_bf16(v[2][q] * sc, v[3][q] * sc); *(LAS u32x2*)(wp + q * CVT_PB) = w; }
    __syncthreads();
    { const LAS unsigned char* rp = T + (tid >> 3) * CVT_PB + (tid & 7) * 32;
      const u32x2 a = *(const LAS u32x2*)rp, b2 = *(const LAS u32x2*)(rp + 8), c = *(const LAS u32x2*)(rp + 16), e = *(const LAS u32x2*)(rp + 24);
      bf16_t* dq = d.dq + kt * 128;
      *(u32x4*)dq = (u32x4){a.x, a.y, b2.x, b2.y}; *(u32x4*)(dq + 8) = (u32x4){c.x, c.y, e.x, e.y}; }
}
constexpr int CVT_A0 = 132, CVT_A1 = CVT_A0 + CVT_NA, CVT_B0 = CVT_A1, CVT_B1 = CVT_B0 + CVT_NB, CVT_C0 = CVT_SPL, CVT_C1 = CVT_C0 + 132 + CVT_NC, CVT_D1 = CVT_NS, CVT_D0 = CVT_D1 - CVT_ND;
static_assert(CVT_B1 <= 1156 && CVT_C1 <= CVT_SPL + 1156 && CVT_D0 >= CVT_SPL + 1156, "side ranges");
__device__ __forceinline__ void cvt_loop(const Params& p, const Frame& F, int w, int nw, int s0, int s1) {
    LAS unsigned char* T0 = F.lds; LAS unsigned char* T1 = F.lds + CVT_TB;
    f32x4 v0[4], v1[4], v2[4], v3[4], v4[4];
    int sI = s0 + w, ktI = 0, sF = sI, ktF = 0; bool iv = sI < s1;
    __syncthreads();
    if (!iv) return;
    CvtStrip dI = cvt_strip(p, F, sI), dF = dI;
#define CVT_ADV_I() do { if (++ktI == dI.nk) { sI += nw; ktI = 0; iv = sI < s1; if (iv) dI = cvt_strip(p, F, sI); } } while (0)
#define CVT_STEP(VI, VF, TB) { if (iv) { cvt_issue(dI, ktI, VI); CVT_ADV_I(); } \
        cvt_finish(F, dF, ktF, VF, TB); if (++ktF == dF.nk) { sF += nw; ktF = 0; if (sF >= s1) break; dF = cvt_strip(p, F, sF); } }
    cvt_issue(dI, ktI, v0); CVT_ADV_I();
    if (iv) { cvt_issue(dI, ktI, v1); CVT_ADV_I(); }
    if (iv) { cvt_issue(dI, ktI, v2); CVT_ADV_I(); }
    if (iv) { cvt_issue(dI, ktI, v3); CVT_ADV_I(); }
    for (;;) { CVT_STEP(v4, v0, T0) CVT_STEP(v0, v1, T1) CVT_STEP(v1, v2, T0) CVT_STEP(v2, v3, T1) CVT_STEP(v3, v4, T0)
               CVT_STEP(v4, v0, T1) CVT_STEP(v0, v1, T0) CVT_STEP(v1, v2, T1) CVT_STEP(v2, v3, T0) CVT_STEP(v3, v4, T1) }
#undef CVT_STEP
#undef CVT_ADV_I
    __syncthreads();
}
__device__ __forceinline__ int pro_total(int sm, int mq0, int mq1) { return CVT_A0 + ((sm & 1) ? 0 : CVT_NA) + ((sm & 2) ? 0 : CVT_NB) + (CVT_C0 - CVT_B1 - mq0) + ((sm & 4) ? 0 : CVT_C1 - CVT_C0) + (CVT_D0 - CVT_C1 - mq1) + ((sm & 8) ? 0 : CVT_D1 - CVT_D0); }
__device__ __forceinline__ int pro_map(int v, int sm, int mq0, int mq1) {
    int s = v;
    if (s < CVT_A0) return s;
    if (sm & 1) s += CVT_NA; else if (s < CVT_A1) return s;
    if (sm & 2) s += CVT_NB; else if (s < CVT_B1) return s;
    if (s < CVT_C0 - mq0) return s;
    s += mq0;
    if (sm & 4) s += CVT_C1 - CVT_C0; else if (s < CVT_C1) return s;
    if (s < CVT_D0 - mq1) return s;
    s += mq1;
    if (sm & 8) s += CVT_D1 - CVT_D0;
    return s;
}
template <bool MAP>
__device__ __forceinline__ void cvt_loop8(const Params& p, const Frame& F, int w, int nw, int s0, int s1, int sm = 0, int mq0 = 0, int mq1 = 0) {
    LAS unsigned char* T0 = F.lds; LAS unsigned char* T1 = F.lds + CVT_TB;
    f32x4 v0[4], v1[4], v2[4], v3[4], v4[4], v5[4], v6[4], v7[4], v8[4];
    int sI = s0 + w, ktI = 0, sF = sI, ktF = 0; bool iv = sI < s1;
    __syncthreads();
    if (!iv) return;
    CvtStrip dI = cvt_strip(p, F, MAP ? pro_map(sI, sm, mq0, mq1) : sI), dF = dI;
#define CVT_ADV_I() do { if (++ktI == dI.nk) { sI += nw; ktI = 0; iv = sI < s1; if (iv) dI = cvt_strip(p, F, MAP ? pro_map(sI, sm, mq0, mq1) : sI); } } while (0)
#define CVT_STEP(VI, VF, TB) { if (iv) { cvt_issue(dI, ktI, VI); CVT_ADV_I(); } \
        cvt_finish(F, dF, ktF, VF, TB); if (++ktF == dF.nk) { sF += nw; ktF = 0; if (sF >= s1) break; dF = cvt_strip(p, F, MAP ? pro_map(sF, sm, mq0, mq1) : sF); } }
    cvt_issue(dI, ktI, v0); CVT_ADV_I();
    if (iv) { cvt_issue(dI, ktI, v1); CVT_ADV_I(); }
    if (iv) { cvt_issue(dI, ktI, v2); CVT_ADV_I(); }
    if (iv) { cvt_issue(dI, ktI, v3); CVT_ADV_I(); }
    if (iv) { cvt_issue(dI, ktI, v4); CVT_ADV_I(); }
    if (iv) { cvt_issue(dI, ktI, v5); CVT_ADV_I(); }
    if (iv) { cvt_issue(dI, ktI, v6); CVT_ADV_I(); }
    if (iv) { cvt_issue(dI, ktI, v7); CVT_ADV_I(); }
    for (;;) { CVT_STEP(v8, v0, T0) CVT_STEP(v0, v1, T1) CVT_STEP(v1, v2, T0) CVT_STEP(v2, v3, T1) CVT_STEP(v3, v4, T0) CVT_STEP(v4, v5, T1) CVT_STEP(v5, v6, T0) CVT_STEP(v6, v7, T1) CVT_STEP(v7, v8, T0) CVT_STEP(v8, v0, T1) CVT_STEP(v0, v1, T0) CVT_STEP(v1, v2, T1) CVT_STEP(v2, v3, T0) CVT_STEP(v3, v4, T1) CVT_STEP(v4, v5, T0) CVT_STEP(v5, v6, T1) CVT_STEP(v6, v7, T0) CVT_STEP(v7, v8, T1) }
#undef CVT_STEP
#undef CVT_ADV_I
    __syncthreads();
}
__device__ __forceinline__ void cvt_item(const Params& p, const Frame& F, int s, int h) {
    LAS unsigned char* T0 = F.lds; LAS unsigned char* T1 = F.lds + CVT_TB;
    const CvtStrip d = cvt_strip(p, F, s); const int k0 = 8 * h;
    f32x4 v0[4], v1[4], v2[4], v3[4];
    cvt_issue(d, k0, v0); cvt_issue(d, k0 + 1, v1); cvt_issue(d, k0 + 2, v2); cvt_issue(d, k0 + 3, v3);
    cvt_finish(F, d, k0, v0, T0); cvt_issue(d, k0 + 4, v0);
    cvt_finish(F, d, k0 + 1, v1, T1); cvt_issue(d, k0 + 5, v1);
    cvt_finish(F, d, k0 + 2, v2, T0); cvt_issue(d, k0 + 6, v2);
    cvt_finish(F, d, k0 + 3, v3, T1); cvt_issue(d, k0 + 7, v3);
    cvt_finish(F, d, k0 + 4, v0, T0); cvt_finish(F, d, k0 + 5, v1, T1); cvt_finish(F, d, k0 + 6, v2, T0); cvt_finish(F, d, k0 + 7, v3, T1);
}
__device__ __forceinline__ void ph_convert_side(const Params& p, const Frame& F0, int ngx, int t0, int t1) {
    const Frame F = fresh(F0);
    int xcd = F.bid & 7, lid = F.bid >> 3, per = F.G >> 3;
    int w = xcd * (per - ngx) + (lid - ngx), nw = 8 * (per - ngx);
    asm volatile("" : "+s"(w), "+s"(nw), "+s"(t0), "+s"(t1));
    if (CVT_SIDE8) cvt_loop8<false>(p, F, w, nw, t0, t1); else cvt_loop(p, F, w, nw, t0, t1);
}
__device__ __forceinline__ void ph_prologue(const Params& p, const Frame& F0) { const Frame F = fresh(F0);
    const int tid = F.tid, lane = F.lane, wid = F.wid;
    {
        LAS float* S = (LAS float*)F.lds; LAS float* R = (LAS float*)(F.lds + 9 * 2048 * 4);
        for (int i = tid; i < 9 * 2048; i += 512) { const int r = i >> 11, k = i & 2047; const float v = r < 8 ? p.c[r * 2048 + k] : p.c_ctx[k]; S[i] = v / (1.0f + expf(-v)); }
        __syncthreads();
        const bool psplit = PRO_SPLIT > 0 && F.G == 256; const bool ada = !psplit || ((F.bid >> 3) & 1) == 0;
        const int ia = psplit ? (F.bid >> 4) * 8 + (F.bid & 7) : F.bid, na = psplit ? 128 : F.G;
        if (ada)
        for (int it = ia; it < 768; it += na) {
            const int l = it / 384, n0 = (it % 384) * 32, col = lane & 31, ksub = lane >> 5;
            const float* W = p.ada_w + (size_t)l * 2048 * 12288 + n0 + col;
            float acc[9];
#pragma unroll
            for (int r = 0; r < 9; ++r) acc[r] = 0.f;
            const int k0 = wid * 256 + ksub * 128;
            for (int kb = 0; kb < 128; kb += 32) {
                float wv[32];
#pragma unroll
                for (int kk = 0; kk < 32; ++kk) wv[kk] = __builtin_nontemporal_load(W + (size_t)(k0 + kb + kk) * 12288);
#pragma unroll
                for (int kk = 0; kk < 32; ++kk) { const int k = k0 + kb + kk;
#pragma unroll
                    for (int r = 0; r < 9; ++r) acc[r] += S[r * 2048 + k] * wv[kk]; } }
#pragma unroll
            for (int r = 0; r < 9; ++r) R[((wid * 2 + ksub) * 9 + r) * 32 + col] = acc[r];
            __syncthreads();
            for (int i = tid; i < 9 * 32; i += 512) { const int r = i >> 5, n = i & 31; float s = 0.f;
#pragma unroll
                for (int q = 0; q < 16; ++q) s += R[(q * 9 + r) * 32 + n];
                F.MOD()[((size_t)l * 9 + r) * 12288 + n0 + n] = s + p.ada_b[l * 12288 + n0 + n]; }
            __syncthreads();
        }
    }
    for (int i = F.bid * 512 + tid; i < 2048 * 64; i += F.G * 512) { const int n = i >> 6, j = i & 63, row = n >> 6, colp = n & 63;
        const float inv = powf(10000.0f, -(float)(j & 31) / 32.0f), ang = (float)(j < 32 ? row : colp) * inv;
        F.ROPEG()[i] = cosf(ang); F.ROPEG()[2048 * 64 + i] = sinf(ang); }
    for (int i = F.bid * 512 + tid; i < 2048 * 32; i += F.G * 512) { const int n = i >> 5, j = i & 31, row = n >> 6, colp = n & 63;
        const float inv = powf(10000.0f, -(float)(j & 15) / 16.0f), ang = (float)(j < 16 ? row : colp) * inv;
        F.ROPEM()[i] = cosf(ang); F.ROPEM()[2048 * 32 + i] = sinf(ang); }
    __syncthreads();
    const int sm = (F.G == 256) ? SIDE_MASK : 0;
    const int mq0 = (F.G == 256) ? CVT_MQ0 : 0, mq1 = (F.G == 256) ? CVT_MQ1 + CVT_TKQ : 0;
    if (PRO_SPLIT > 0 && F.G == 256) {
        if (((F.bid >> 3) & 1) != 0) cvt_loop8<true>(p, F, (F.bid >> 4) * 8 + (F.bid & 7), 128, 0, PRO_SPLIT, sm, mq0, mq1);
        cvt_loop8<true>(p, F, F.bid, F.G, PRO_SPLIT, pro_total(sm, mq0, mq1), sm, mq0, mq1);
    } else
    cvt_loop8<true>(p, F, F.bid, F.G, 0, pro_total(sm, mq0, mq1), sm, mq0, mq1);
    if (false) {
        cvt_loop(p, F, F.bid, F.G, 0, CVT_A0);
        if (!(sm & 1)) cvt_loop(p, F, F.bid, F.G, CVT_A0, CVT_A1);
        if (!(sm & 2)) cvt_loop(p, F, F.bid, F.G, CVT_B0, CVT_B1);
        cvt_loop(p, F, F.bid, F.G, CVT_B1, CVT_C0);
        if (!(sm & 4)) cvt_loop(p, F, F.bid, F.G, CVT_C0, CVT_C1);
        cvt_loop(p, F, F.bid, F.G, CVT_C1, CVT_D0);
        if (!(sm & 8)) cvt_loop(p, F, F.bid, F.G, CVT_D0, CVT_D1);
    }
}

struct N1Row { f32x4 xv[8]; int sv; };
__device__ __forceinline__ N1Row n1_load(const Params& p, const Frame& F, int r, int mode, int lane) {
    N1Row x; const int b = r / TPB, t = r % TPB;
    const float* src = (mode == 0) ? (t < 256 ? p.ctx + ((size_t)b * 256 + t) * DM : p.x + ((size_t)b * 2048 + (t - 256)) * DM) : F.X() + (size_t)r * DM;
#pragma unroll
    for (int i = 0; i < 8; ++i) x.xv[i] = *(const f32x4*)(src + (i * 64 + lane) * 4);
    x.sv = (mode != 0 && lane < 16) ? F.TOKSLOT()[(size_t)r * 16 + lane] : -1;
    return x;
}
__device__ __forceinline__ void n1_combine(const Frame& F, N1Row& x, int r, int lp, int lane) {
    const int b = r / TPB, t = r % TPB, mr = t < 256 ? 8 : b;
    const float* g2 = F.MOD() + ((size_t)lp * 9 + mr) * 12288 + 5 * 2048;
    f32x4 ac[8];
#pragma unroll
    for (int i = 0; i < 8; ++i) ac[i] = (f32x4){0.f, 0.f, 0.f, 0.f};
    unsigned long long mask = __ballot(x.sv >= 0);
    while (mask) {
        const int e0 = __builtin_ctzll(mask); mask &= mask - 1;
        const bool two = mask != 0ull; const int e1 = two ? __builtin_ctzll(mask) : e0; if (two) mask &= mask - 1;
        const int s0 = __builtin_amdgcn_readlane(x.sv, e0), s1 = __builtin_amdgcn_readlane(x.sv, e1);
        const bf16_t* y0 = F.Y() + (size_t)s0 * 2048 + lane * 4; const bf16_t* y1 = F.Y() + (size_t)s1 * 2048 + lane * 4;
        u32x2 w0[8], w1[8];
#pragma unroll
        for (int i = 0; i < 8; ++i) { w0[i] = *(const u32x2*)(y0 + i * 256); w1[i] = *(const u32x2*)(y1 + i * 256); }
#pragma unroll
        for (int i = 0; i < 8; ++i) { ac[i] += (f32x4){bflo(w0[i].x), bfhi(w0[i].x), bflo(w0[i].y), bfhi(w0[i].y)};
            if (two) ac[i] += (f32x4){bflo(w1[i].x), bfhi(w1[i].x), bflo(w1[i].y), bfhi(w1[i].y)}; }
    }
#pragma unroll
    for (int i = 0; i < 8; ++i) x.xv[i] += *(const f32x4*)(g2 + (i * 64 + lane) * 4) * ac[i];
}
__device__ __forceinline__ void n1_finish(const Params& p, const Frame& F, const N1Row& x, int r, int l, int mode, int lane) {
    const int b = r / TPB, t = r % TPB, mr = t < 256 ? 8 : b;
    if (mode == 2) { float* dst = p.out + ((size_t)b * 2048 + (t - 256)) * DM;
#pragma unroll
        for (int i = 0; i < 8; ++i) *(f32x4*)(dst + (i * 64 + lane) * 4) = x.xv[i];
        return; }
    if (mode != 0) { float* dst = F.X() + (size_t)r * DM;
#pragma unroll
      for (int i = 0; i < 8; ++i) *(f32x4*)(dst + (i * 64 + lane) * 4) = x.xv[i]; }
    float ss = 0.f;
#pragma unroll
    for (int i = 0; i < 8; ++i) ss += (x.xv[i][0] * x.xv[i][0] + x.xv[i][1] * x.xv[i][1]) + (x.xv[i][2] * x.xv[i][2] + x.xv[i][3] * x.xv[i][3]);
    ss = wsum64(ss);
    const float rstd = 1.0f / sqrtf(ss * (1.0f / DM) + EPSN);
    const float* md = F.MOD() + ((size_t)l * 9 + mr) * 12288; const float* nw = p.norm1 + (size_t)l * DM;
    bf16_t* hp = F.H() + (size_t)r * DM;
#pragma unroll
    for (int i = 0; i < 8; ++i) { const int d = (i * 64 + lane) * 4;
        const f32x4 g = *(const f32x4*)(nw + d), sh = *(const f32x4*)(md + d), sc = *(const f32x4*)(md + 2048 + d);
        const f32x4 hv = x.xv[i] * rstd * g * (sc + 1.0f) + sh;
        u32x2 w; w.x = cvt_pk_bf16(hv[0], hv[1]); w.y = cvt_pk_bf16(hv[2], hv[3]); *(u32x2*)(hp + d) = w; }
}
template <int MODE, int PF>
__device__ __forceinline__ void ph_norm1_t(const Params& p, const Frame& F0, int l) { const Frame F = fresh(F0);
    constexpr int mode = MODE;
    const int lane = F.lane, st = F.G * 8; const int lp = (mode == 2) ? l : l - 1;
    int r = F.bid * 8 + F.wid;
    N1Row a = n1_load(p, F, r < NTOK ? r : 0, mode, lane), b2 = n1_load(p, F, (r + st < NTOK) ? r + st : 0, mode, lane);
    for (; r < NTOK; r += 2 * st) {
        const int r2 = r + st, rn = r + 2 * st, rn2 = r + 3 * st; const bool has2 = r2 < NTOK;
        N1Row an, bn; if constexpr (PF >= 1) an = n1_load(p, F, rn < NTOK ? rn : 0, mode, lane);
        if constexpr (PF >= 2) bn = n1_load(p, F, rn2 < NTOK ? rn2 : 0, mode, lane);
        const bool ok1 = !(mode == 2 && (r % TPB) < 256), ok2 = has2 && !(mode == 2 && (r2 % TPB) < 256);
        if (mode != 0) { if (ok1) n1_combine(F, a, r, lp, lane); if (ok2) n1_combine(F, b2, r2, lp, lane); }
        if (ok1) n1_finish(p, F, a, r, l, mode, lane);
        if (ok2) n1_finish(p, F, b2, r2, l, mode, lane);
        if constexpr (PF < 1) an = n1_load(p, F, rn < NTOK ? rn : 0, mode, lane);
        if constexpr (PF < 2) bn = n1_load(p, F, rn2 < NTOK ? rn2 : 0, mode, lane);
        a = an; b2 = bn;
    }
}
__device__ __forceinline__ void ph_norm1(const Params& p, const Frame& F0, int l, int mode) {
    if (mode == 0) ph_norm1_t<0, 2>(p, F0, l); else if (mode == 1) ph_norm1_t<1, 0>(p, F0, l); else ph_norm1_t<2, 1>(p, F0, l);
}

struct PrepRow { u32x4 q0, q1, kk, qa; float gate; };
__device__ __forceinline__ PrepRow prep_load(const Frame& F, int r, int lane) {
    const bf16_t* prow = F.P() + (size_t)r * NPW; PrepRow x;
    x.q0 = *(const u32x4*)(prow + 2048 + lane * 8); x.q1 = *(const u32x4*)(prow + 2560 + lane * 8);
    x.kk = *(const u32x4*)(prow + (lane < 32 ? 3072 + lane * 8 : 4096 + (lane - 32) * 8));
    x.qa = *(const u32x4*)(prow + 3584 + lane * 8);
    x.gate = F.PG()[(size_t)r * 128 + (lane & 15)];
    return x;
}
__device__ __forceinline__ void prep_row(const Params& p, const Frame& F, int l, int r, int lane, const PrepRow& x) {
    const int b = r / TPB, t = r % TPB; const bool lat = t >= 256; const int n = lat ? t - 256 : 0;
    const int d0 = (lane & 15) * 8; const bool second = (lane & 8) != 0;
    const float* cs = F.ROPEG() + (size_t)n * 64 + (d0 & 63); const float* sn = cs + 2048 * 64;
    float csv[8], snv[8];
    { const f32x4 c0 = *(const f32x4*)cs, c1 = *(const f32x4*)(cs + 4), s0 = *(const f32x4*)sn, s1 = *(const f32x4*)(sn + 4);
#pragma unroll
      for (int j = 0; j < 4; ++j) { csv[j] = c0[j]; csv[4 + j] = c1[j]; snv[j] = s0[j]; snv[4 + j] = s1[j]; } }
#pragma unroll
    for (int ps = 0; ps < 2; ++ps) {
        float v[8]; unpack8(ps ? x.q1 : x.q0, v);
        float ss = 0.f;
#pragma unroll
        for (int j = 0; j < 8; ++j) ss += v[j] * v[j];
        ss = gsum16(ss); const float rs = 1.0f / sqrtf(ss * (1.0f / 128.0f) + EPSN);
        const float* gn = p.gqa_q_norm + l * 128 + d0;
        float y[8];
#pragma unroll
        for (int j = 0; j < 8; ++j) y[j] = v[j] * rs * gn[j];
#pragma unroll
        for (int j = 0; j < 8; ++j) { const float o = __shfl_xor(y[j], 8); if (lat) y[j] = second ? (y[j] * csv[j] + o * snv[j]) : (y[j] * csv[j] - o * snv[j]); }
#pragma unroll
        for (int j = 0; j < 8; ++j) y[j] *= QSCALE_G;
        *(u32x4*)(F.QG() + (size_t)r * 1024 + ps * 512 + lane * 8) = pack8(y);
    }
    {
        const bool isk = lane < 32;
        float v[8]; unpack8(x.kk, v);
        float ss = 0.f;
#pragma unroll
        for (int j = 0; j < 8; ++j) ss += v[j] * v[j];
        const float s16 = gsum16(ss), s32 = s16 + __shfl_xor(s16, 16);
        const float rs = 1.0f / sqrtf((isk ? s16 * (1.0f / 128.0f) : s32 * (1.0f / 256.0f)) + EPSN);
        const float* gn = isk ? p.gqa_k_norm + l * 128 + d0 : p.mla_kva_norm + l * 256 + (lane - 32) * 8;
        float y[8];
#pragma unroll
        for (int j = 0; j < 8; ++j) y[j] = v[j] * rs * gn[j];
#pragma unroll
        for (int j = 0; j < 8; ++j) { const float o = __shfl_xor(y[j], 8); if (lat && isk) y[j] = second ? (y[j] * csv[j] + o * snv[j]) : (y[j] * csv[j] - o * snv[j]); }
        bf16_t* dst = isk ? F.KG() + (size_t)r * 256 + lane * 8 : F.KVA() + (size_t)r * 256 + (lane - 32) * 8;
        *(u32x4*)dst = pack8(y);
    }
    {
        float v[8]; unpack8(x.qa, v);
        float ss = 0.f;
#pragma unroll
        for (int j = 0; j < 8; ++j) ss += v[j] * v[j];
        ss = wsum64(ss); const float rs = 1.0f / sqrtf(ss * (1.0f / 512.0f) + EPSN);
        const float* gn = p.mla_qa_norm + l * 512 + lane * 8;
        float y[8];
#pragma unroll
        for (int j = 0; j < 8; ++j) y[j] = v[j] * rs * gn[j];
        *(u32x4*)(F.QA() + (size_t)r * 512 + lane * 8) = pack8(y);
    }
    if (lane < 16) {
        const float g = x.gate + p.b_gates[l * 16 + lane];
        const int type = lane >> 2, head = lane & 3, dir = type >> 1;
        const float val = (type & 1) ? (fminf(g, 0.f) - log1pf(expf(-fabsf(g)))) : g;
        float* dstp = ((type & 1) ? F.GF() : F.GI()) + ((size_t)(dir * 8 + b) * 4 + head) * TPB + t;
        *dstp = val;
    }
}
__device__ __forceinline__ void ph_prep(const Params& p, const Frame& F0, int l) { const Frame F = fresh(F0);
    const int lane = F.lane, st = F.G * 8;
    int r = F.bid * 8 + F.wid;
    PrepRow a = prep_load(F, r < NTOK ? r : 0, lane), b2 = prep_load(F, (r + st < NTOK) ? r + st : 0, lane);
    for (; r < NTOK; r += 2 * st) {
        const int r2 = r + st, rn = r + 2 * st, rn2 = r + 3 * st; const bool has2 = r2 < NTOK;
        const PrepRow an = prep_load(F, rn < NTOK ? rn : 0, lane), bn = prep_load(F, rn2 < NTOK ? rn2 : 0, lane);
        prep_row(p, F, l, r, lane, a);
        if (has2) prep_row(p, F, l, r2, lane, b2);
        a = an; b2 = bn;
    }
}

struct MlaRow { u32x2 q[4], kn[4]; f32x4 kr; };
__device__ __forceinline__ MlaRow mla_load(const Frame& F, int r, int lane) {
    MlaRow x; const bool act = lane < 48, rp = lane >= 32 && lane < 48;
#pragma unroll
    for (int hh = 0; hh < 4; ++hh) {
        x.q[hh] = act ? *(const u32x2*)(F.MQ() + (size_t)r * 768 + hh * 192 + lane * 4) : (u32x2){0u, 0u};
        x.kn[hh] = (lane < 32) ? *(const u32x2*)(F.MKV() + (size_t)r * 1024 + hh * 256 + lane * 4) : (u32x2){0u, 0u}; }
    x.kr = rp ? *(const f32x4*)(F.PG() + (size_t)r * 128 + 16 + (lane - 32) * 4) : (f32x4){0.f, 0.f, 0.f, 0.f};
    return x;
}
__device__ __forceinline__ void mla_row(const Params& p, const Frame& F, int l, int r, int lane, const MlaRow& x) {
    const int t = r % TPB; const bool lat = t >= 256; const int n = lat ? t - 256 : 0;
    const bool act = lane < 48, rp = lane >= 32 && lane < 48;
    const float* cs = F.ROPEM() + (size_t)n * 32 + ((lane - 32) & 7) * 4; const float* sn = cs + 2048 * 32; const bool second = (lane & 8) != 0;
    float csv[4], snv[4];
    { const f32x4 c0 = rp ? *(const f32x4*)cs : (f32x4){1.f, 1.f, 1.f, 1.f}, s0 = rp ? *(const f32x4*)sn : (f32x4){0.f, 0.f, 0.f, 0.f};
#pragma unroll
      for (int j = 0; j < 4; ++j) { csv[j] = c0[j]; snv[j] = s0[j]; } }
#pragma unroll
    for (int pass = 0; pass < 8; ++pass) {
        const int hh = pass & 3; const bool isq = pass < 4;
        float v[4];
        if (isq) { const u32x2 w = x.q[hh]; v[0] = bflo(w.x); v[1] = bfhi(w.x); v[2] = bflo(w.y); v[3] = bfhi(w.y); }
        else { const u32x2 w = x.kn[hh]; v[0] = rp ? x.kr[0] : bflo(w.x); v[1] = rp ? x.kr[1] : bfhi(w.x); v[2] = rp ? x.kr[2] : bflo(w.y); v[3] = rp ? x.kr[3] : bfhi(w.y); }
        float ss = (v[0] * v[0] + v[1] * v[1]) + (v[2] * v[2] + v[3] * v[3]);
        ss = wsum64(ss); const float rs = 1.0f / sqrtf(ss * (1.0f / 192.0f) + EPSN);
        const float* gn = (isq ? p.mla_q_norm : p.mla_k_norm) + l * 192 + (act ? lane * 4 : 0);
        float y[4];
#pragma unroll
        for (int j = 0; j < 4; ++j) y[j] = v[j] * rs * gn[j];
#pragma unroll
        for (int j = 0; j < 4; ++j) { const float o = __shfl_xor(y[j], 8); if (lat && rp) y[j] = second ? (y[j] * csv[j] + o * snv[j]) : (y[j] * csv[j] - o * snv[j]); }
        if (isq) {
#pragma unroll
            for (int j = 0; j < 4; ++j) y[j] *= QSCALE_M; }
        if (act) { u32x2 w; w.x = cvt_pk_bf16(y[0], y[1]); w.y = cvt_pk_bf16(y[2], y[3]);
            *(u32x2*)((isq ? F.QM() : F.KM()) + (size_t)r * 768 + hh * 192 + lane * 4) = w; }
    }
}
__device__ __forceinline__ void ph_mla_prep(const Params& p, const Frame& F0, int l) { const Frame F = fresh(F0);
    const int lane = F.lane, st = F.G * 8;
    int r = F.bid * 8 + F.wid;
    MlaRow a = mla_load(F, r < NTOK ? r : 0, lane), b2 = mla_load(F, (r + st < NTOK) ? r + st : 0, lane);
    for (; r < NTOK; r += 2 * st) {
        const int r2 = r + st, rn = r + 2 * st, rn2 = r + 3 * st; const bool has2 = r2 < NTOK;
        const MlaRow an = mla_load(F, rn < NTOK ? rn : 0, lane), bn = mla_load(F, rn2 < NTOK ? rn2 : 0, lane);
        mla_row(p, F, l, r, lane, a);
        if (has2) mla_row(p, F, l, r2, lane, b2);
        a = an; b2 = bn;
    }
}

__device__ __forceinline__ void mp_block(const Params& p, const Frame& F, int l, int row0) {
    const int lane = F.lane; int r = row0 + F.wid;
    MlaRow a = mla_load(F, r, lane), b2 = mla_load(F, r + 8, lane);
    for (int k = 0; k < 4; ++k) { const bool more = k + 1 < 4;
        const MlaRow an = mla_load(F, more ? r + 16 : r, lane), bn = mla_load(F, more ? r + 24 : r, lane);
        mla_row(p, F, l, r, lane, a); mla_row(p, F, l, r + 8, lane, b2); a = an; b2 = bn; r += 16; }
}
struct MoRow { u32x4 a, b; u32x4 o; };
__device__ __forceinline__ MoRow mo_load(const Frame& F, int r, int lane) {
    MoRow x; x.a = *(const u32x4*)((const bf16_t*)F.HF() + (size_t)r * 512 + lane * 8); x.b = *(const u32x4*)((const bf16_t*)F.HB() + (size_t)r * 512 + lane * 8);
    x.o = *(const u32x4*)(F.P() + (size_t)r * NPW + 1536 + lane * 8); return x;
}
__device__ __forceinline__ void mo_row(const Params& p, const Frame& F, int l, int r, int lane, const MoRow& x) {
    float fa[8], fb[8]; unpack8(x.a, fa); unpack8(x.b, fb);
    float v[8];
#pragma unroll
    for (int j = 0; j < 8; ++j) v[j] = fa[j] + fb[j];
    float ss = 0.f;
#pragma unroll
    for (int j = 0; j < 8; ++j) ss += v[j] * v[j];
    ss = gsum16(ss); const float rs = 1.0f / sqrtf(ss * (1.0f / 128.0f) + EPSN);
    float o[8]; unpack8(x.o, o);
    const float* gn = p.ml_norm + l * 512 + lane * 8;
    float y[8];
#pragma unroll
    for (int j = 0; j < 8; ++j) y[j] = v[j] * rs * gn[j] / (1.0f + __expf(-o[j]));
    *(u32x4*)(F.MIX() + (size_t)r * 2048 + lane * 8) = pack8(y);
}
__device__ __forceinline__ void mo_block(const Params& p, const Frame& F, int l, int row0) {
    const int lane = F.lane; int r = row0 + F.wid;
    MoRow a = mo_load(F, r, lane), b2 = mo_load(F, r + 8, lane);
    for (int k = 0; k < 8; ++k) { const bool more = k + 1 < 8;
        const MoRow an = mo_load(F, more ? r + 16 : r, lane), bn = mo_load(F, more ? r + 24 : r, lane);
        mo_row(p, F, l, r, lane, a); mo_row(p, F, l, r + 8, lane, b2); a = an; b2 = bn; r += 16; }
}
__device__ __forceinline__ int queue_pop(const Frame& F, unsigned* ctr) {
    volatile LAS int* slot = (volatile LAS int*)(F.lds + LDS_MISC + 16);
    __syncthreads();
    if (F.tid == 0) *slot = (int)__hip_atomic_fetch_add(ctr, 1u, __ATOMIC_RELAXED, __HIP_MEMORY_SCOPE_AGENT);
    __syncthreads();
    return __builtin_amdgcn_readfirstlane(*slot);
}
__device__ __forceinline__ void ph_mixer(const Params& p, const Frame& F0, int l, int rep, int skip) { const Frame F = fresh(F0);
    const bool need_ctx = (l + 1 < NLAYER);
    if (!(DIS & (1 << 16)) && !((skip & 1) && rep) && F.bid < 64) {
        const int sid = F.bid, dir = sid & 1, h = (sid >> 1) & 3, b = sid >> 3;
        const size_t go = ((size_t)(dir * 8 + b) * 4 + h) * TPB;
        ml::mlstm_seq(F.lds, F.P(), F.GI() + go, F.GF() + go, (bf16_t*)(dir ? F.HB() : F.HF()), b, h, dir, need_ctx);
        if (MO_IN_MIXER) {
            asm volatile("s_waitcnt vmcnt(0)" ::: "memory"); __syncthreads();
            if (F.tid == 0) { __builtin_amdgcn_fence(__ATOMIC_RELEASE, "agent");
                __hip_atomic_fetch_add(F.ctl() + CTL_Q / 4 + (32 + l * 8 + b) * 64, 1u, __ATOMIC_RELAXED, __HIP_MEMORY_SCOPE_AGENT); }
        }
    }
    bool umaxM, umaxG;
    { float a = 0.f, b2 = 0.f, c = 0.f, d = 0.f; const int lane = F.lane;
      for (int i = lane; i < 192; i += 64) { a = fmaxf(a, fabsf(p.mla_q_norm[l * 192 + i])); b2 = fmaxf(b2, fabsf(p.mla_k_norm[l * 192 + i])); }
      for (int i = lane; i < 128; i += 64) { c = fmaxf(c, fabsf(p.gqa_q_norm[l * 128 + i])); d = fmaxf(d, fabsf(p.gqa_k_norm[l * 128 + i])); }
#pragma unroll
      for (int o = 32; o > 0; o >>= 1) { a = fmaxf(a, __shfl_xor(a, o)); b2 = fmaxf(b2, __shfl_xor(b2, o)); c = fmaxf(c, __shfl_xor(c, o)); d = fmaxf(d, __shfl_xor(d, o)); }
      const float bM = 13.8564065f * 1.44269504f * a * b2, bG = 11.3137085f * 1.44269504f * c * d;
      umaxM = __builtin_amdgcn_readfirstlane(!(bM < 96.f)) != 0; umaxG = __builtin_amdgcn_readfirstlane(!(bG < 96.f)) != 0; }
    if (!(DIS & (1 << 17)) && !((skip & 2) && rep)) {
        unsigned* ctr = F.ctl() + CTL_Q / 4 + (rep * 4 + l * 2 + 0) * 64;
        const int nA = 256 + (need_ctx ? 32 : 0), nP = (MP_IN_MIXER && !rep) ? 288 : 0;
        if (nP) {
            unsigned* ctrP = F.ctl() + CTL_Q / 4 + (16 + l) * 64;
            for (;;) {
                const int ip = queue_pop(F, ctrP); if (ip >= nP) break;
                mp_block(p, F, l, ip * 64);
                asm volatile("s_waitcnt vmcnt(0)" ::: "memory"); __syncthreads();
                if (F.tid == 0) { __builtin_amdgcn_fence(__ATOMIC_RELEASE, "agent");
                    __hip_atomic_fetch_add(F.ctl() + CTL_Q / 4 + (64 + l) * 64, 1u, __ATOMIC_RELAXED, __HIP_MEMORY_SCOPE_AGENT); }
            }
            if (F.tid == 0) { unsigned* fl = F.ctl() + CTL_Q / 4 + (64 + l) * 64;
                while (__hip_atomic_load(fl, __ATOMIC_RELAXED, __HIP_MEMORY_SCOPE_AGENT) < 288u) __builtin_amdgcn_s_sleep(2);
                __builtin_amdgcn_fence(__ATOMIC_ACQUIRE, "agent"); asm volatile("s_waitcnt vmcnt(0)" ::: "memory"); }
            __syncthreads();
        }
        for (;;) {
            const int it = queue_pop(F, ctr); if (it >= nA) break;
            int b, h, q0, seq;
            if (it < 256) { b = it >> 5; h = (it >> 3) & 3; q0 = 256 + (it & 7) * 256; seq = TPB; } else { const int j = it - 256; b = j >> 2; h = j & 3; q0 = 0; seq = 256; }
            const size_t rq = (size_t)b * TPB + q0, rk = (size_t)b * TPB;
            att::ATTN_BODY<192, 768, 768, 1024, 2048>(F.QM() + rq * 768 + h * 192, F.KM() + rk * 768 + h * 192, F.MKV() + rk * 1024 + h * 256 + 128, F.MIX() + rq * 2048 + 1536 + h * 128, seq, F.lds, umaxM);
        }
    }
    if (!(DIS & (1 << 18)) && !((skip & 4) && rep)) for (int rep2 = 0; rep2 < 1 + ((REP >> 20) & 1); ++rep2) {
        unsigned* ctr = F.ctl() + CTL_Q / 4 + (rep2 * 8 + rep * 4 + l * 2 + 1) * 64;
        constexpr int NFULL = 512 - GQA_SPLIT, NLAT = NFULL + 2 * GQA_SPLIT;
        const int nB = NLAT + (need_ctx ? 64 : 0), nMO = (MO_IN_MIXER && !rep) ? 144 : 0;
        const int nCV = (F.G == 256 && !rep) ? 2 * (l == 0 ? CVT_MQ0 : CVT_MQ1) : 0, cvbase = l == 0 ? CVT_C0 - CVT_MQ0 : CVT_D0 - CVT_MQ1;
        for (;;) {
            const int it = queue_pop(F, ctr); if (it >= nB + nMO + nCV) break;
            if (it >= nB + nMO) { const int j = it - nB - nMO; cvt_item(p, F, cvbase + (j >> 1), j & 1); continue; }
            if (it >= nB) {
                const int i = it - nB, bb = i / 18, ti = i % 18;
                if (!need_ctx && ti < 2) continue;
                if (F.tid == 0) { unsigned* fl = F.ctl() + CTL_Q / 4 + (32 + l * 8 + bb) * 64;
                    while (__hip_atomic_load(fl, __ATOMIC_RELAXED, __HIP_MEMORY_SCOPE_AGENT) < 8u) __builtin_amdgcn_s_sleep(2);
                    __builtin_amdgcn_fence(__ATOMIC_ACQUIRE, "agent"); asm volatile("s_waitcnt vmcnt(0)" ::: "memory"); }
                __syncthreads();
                mo_block(p, F, l, i * 128);
                continue;
            }
            int b, hq, q0, seq, nact = 8;
            if (it < NLAT) { int f = it, hf = 0; if (it >= NFULL) { f = NFULL + ((it - NFULL) >> 1); hf = (it - NFULL) & 1; nact = 4; }
                b = f >> 6; hq = (f >> 3) & 7; q0 = 256 + (f & 7) * 256 + hf * 128; seq = TPB; }
            else { const int j = it - NLAT; b = j >> 3; hq = j & 7; q0 = 0; seq = 256; }
            const size_t rq = (size_t)b * TPB + q0, rk = (size_t)b * TPB; const int kv = hq >> 2;
            att::ATTN_BODY<128, 1024, 256, NPW, 2048>(F.QG() + rq * 1024 + hq * 128, F.KG() + rk * 256 + kv * 128, F.P() + rk * NPW + 3328 + kv * 128, F.MIX() + rq * 2048 + 512 + hq * 128, seq, F.lds, umaxG, ((rep || rep2) && PROBE_NACT >= 0) ? PROBE_NACT : nact);
        }
    }
}

__device__ __forceinline__ void ph_mlstm_out(const Params& p, const Frame& F0, int l) { const Frame F = fresh(F0);
    const int lane = F.lane, st = F.G * 8; const bool need_ctx = (l + 1 < NLAYER);
    int r = F.bid * 8 + F.wid;
    MoRow a = mo_load(F, r < NTOK ? r : 0, lane), b2 = mo_load(F, (r + st < NTOK) ? r + st : 0, lane);
    for (; r < NTOK; r += 2 * st) {
        const int r2 = r + st, rn = r + 2 * st, rn2 = r + 3 * st; const bool has2 = r2 < NTOK;
        const MoRow an = mo_load(F, rn < NTOK ? rn : 0, lane), bn = mo_load(F, rn2 < NTOK ? rn2 : 0, lane);
        const bool ok1 = need_ctx || (r % TPB) >= 256, ok2 = has2 && (need_ctx || (r2 % TPB) >= 256);
        if (ok1) mo_row(p, F, l, r, lane, a);
        if (ok2) mo_row(p, F, l, r2, lane, b2);
        a = an; b2 = bn;
    }
}

__device__ __forceinline__ float router_reduce16(float (&lg)[16], int lane) {
    const bool b5 = lane & 32, b4 = lane & 16, b3 = lane & 8, b2 = lane & 4;
    float k8[8], k4[4], k2[2];
#pragma unroll
    for (int j = 0; j < 8; ++j) { const float snd = b5 ? lg[j] : lg[8 + j]; const float rcv = __shfl_xor(snd, 32); k8[j] = (b5 ? lg[8 + j] : lg[j]) + rcv; }
#pragma unroll
    for (int j = 0; j < 4; ++j) { const float snd = b4 ? k8[j] : k8[4 + j]; const float rcv = __shfl_xor(snd, 16); k4[j] = (b4 ? k8[4 + j] : k8[j]) + rcv; }
#pragma unroll
    for (int j = 0; j < 2; ++j) { const float snd = b3 ? k4[j] : k4[2 + j]; const float rcv = __shfl_xor(snd, 8); k2[j] = (b3 ? k4[2 + j] : k4[j]) + rcv; }
    float v; { const float snd = b2 ? k2[0] : k2[1]; const float rcv = __shfl_xor(snd, 4); v = (b2 ? k2[1] : k2[0]) + rcv; }
    v += __shfl_xor(v, 2); v += __shfl_xor(v, 1);
    return v;
}
__device__ __forceinline__ void ph_router_valu(const Params& p, const Frame& F0, int l) { const Frame F = fresh(F0);
    const int lane = F.lane, tid = F.tid; const bool need_ctx = (l + 1 < NLAYER);
    LAS float* WR = (LAS float*)F.lds;
    for (int rp1 = 0; rp1 < 1 + RPROBE1; ++rp1) { __syncthreads();
    { const f32x4* w4 = (const f32x4*)(p.w_router + (size_t)l * 2048 * 16);
      f32x4 wv[16];
#pragma unroll
      for (int k = 0; k < 16; ++k) wv[k] = w4[tid + k * 512];
#pragma unroll
      for (int k = 0; k < 16; ++k) { const int i4 = tid + k * 512, d = i4 >> 2, e0 = (i4 & 3) * 4;
#pragma unroll
          for (int j = 0; j < 4; ++j) WR[(e0 + j) * 2052 + d] = wv[k][j]; } }
    __syncthreads(); }
    const int st = F.G * 8; const float* nwl = p.norm2 + (size_t)l * DM + lane * 4;
    const LAS float* wrl = WR + lane * 4;
    for (int rp2 = 0; rp2 < 1 + RPROBE2; ++rp2)
    for (int r0 = F.bid * 8 + F.wid; r0 < NTOK; r0 += 2 * st) {
        const int ra = r0, rb = (r0 + st < NTOK) ? r0 + st : r0;
        const int ba = ra / TPB, ta = ra % TPB, bb = rb / TPB, tb = rb % TPB;
        const bool va = need_ctx || ta >= 256, vb = (r0 + st < NTOK) && (need_ctx || tb >= 256);
        const float* xa = F.X() + (size_t)ra * DM + lane * 4; const float* xb = F.X() + (size_t)rb * DM + lane * 4;
        const float* ma = F.MOD() + ((size_t)l * 9 + (ta < 256 ? 8 : ba)) * 12288 + 3 * 2048 + lane * 4;
        const float* mb = F.MOD() + ((size_t)l * 9 + (tb < 256 ? 8 : bb)) * 12288 + 3 * 2048 + lane * 4;
        bf16_t* ha = F.H() + (size_t)ra * DM + lane * 4; bf16_t* hb = F.H() + (size_t)rb * DM + lane * 4;
        const LAS float* wr2 = wrl; asm volatile("" : "+v"(wr2));
        f32x4 xva[8], xvb[8];
#pragma unroll
        for (int i = 0; i < 8; ++i) { xva[i] = *(const f32x4*)(xa + i * 256); xvb[i] = *(const f32x4*)(xb + i * 256); }
        float ssa = 0.f, ssb = 0.f;
#pragma unroll
        for (int i = 0; i < 8; ++i) { ssa += (xva[i][0] * xva[i][0] + xva[i][1] * xva[i][1]) + (xva[i][2] * xva[i][2] + xva[i][3] * xva[i][3]);
                                      ssb += (xvb[i][0] * xvb[i][0] + xvb[i][1] * xvb[i][1]) + (xvb[i][2] * xvb[i][2] + xvb[i][3] * xvb[i][3]); }
        ssa = wsum64(ssa); ssb = wsum64(ssb);
        const float rsa = 1.0f / sqrtf(ssa * (1.0f / DM) + EPSN), rsb = 1.0f / sqrtf(ssb * (1.0f / DM) + EPSN);
        float lga[16], lgb[16];
#pragma unroll
        for (int e = 0; e < 16; ++e) { lga[e] = 0.f; lgb[e] = 0.f; }
#pragma unroll
        for (int i = 0; i < 8; ++i) {
            const f32x4 g = *(const f32x4*)(nwl + i * 256);
            xva[i] = xva[i] * rsa * g * (*(const f32x4*)(ma + 2048 + i * 256) + 1.0f) + *(const f32x4*)(ma + i * 256);
            xvb[i] = xvb[i] * rsb * g * (*(const f32x4*)(mb + 2048 + i * 256) + 1.0f) + *(const f32x4*)(mb + i * 256);
            if (va) { u32x2 w; w.x = cvt_pk_bf16(xva[i][0], xva[i][1]); w.y = cvt_pk_bf16(xva[i][2], xva[i][3]); *(u32x2*)(ha + i * 256) = w; }
            if (vb) { u32x2 w; w.x = cvt_pk_bf16(xvb[i][0], xvb[i][1]); w.y = cvt_pk_bf16(xvb[i][2], xvb[i][3]); *(u32x2*)(hb + i * 256) = w; }
        }
        if (!(RPROBE_SKIP && rp2 > 0)) {
            f32x4 wcur[4], wnxt[4];
#pragma unroll
            for (int e = 0; e < 4; ++e) wcur[e] = *(const LAS f32x4*)(wr2 + e * 2052);
#pragma unroll
            for (int g = 0; g < 32; ++g) {
                const int i = g >> 2, eg = g & 3;
                if (g + 1 < 32) { const int i2 = (g + 1) >> 2, eg2 = (g + 1) & 3;
#pragma unroll
                    for (int e = 0; e < 4; ++e) wnxt[e] = *(const LAS f32x4*)(wr2 + (eg2 * 4 + e) * 2052 + i2 * 256); }
                const f32x4 hva = xva[i], hvb = xvb[i];
#pragma unroll
                for (int e = 0; e < 4; ++e) {
                    float a = lga[eg * 4 + e], bq = lgb[eg * 4 + e];
                    a = fmaf(hva[0], wcur[e][0], a); a = fmaf(hva[1], wcur[e][1], a); a = fmaf(hva[2], wcur[e][2], a); a = fmaf(hva[3], wcur[e][3], a);
                    bq = fmaf(hvb[0], wcur[e][0], bq); bq = fmaf(hvb[1], wcur[e][1], bq); bq = fmaf(hvb[2], wcur[e][2], bq); bq = fmaf(hvb[3], wcur[e][3], bq);
                    lga[eg * 4 + e] = a; lgb[eg * 4 + e] = bq; }
#pragma unroll
                for (int e = 0; e < 4; ++e) asm volatile("" : "+v"(lga[eg * 4 + e]), "+v"(lgb[eg * 4 + e]));
#pragma unroll
                for (int e = 0; e < 4; ++e) wcur[e] = wnxt[e];
                __builtin_amdgcn_sched_barrier(0);
            }
        }
        if (!(RPROBE_SKIP && rp2 > 0))
#pragma unroll
        for (int q = 0; q < 2; ++q) {
            const float v = q ? router_reduce16(lgb, lane) : router_reduce16(lga, lane);
            float mx = v;
#pragma unroll
            for (int o = 4; o < 64; o <<= 1) mx = fmaxf(mx, __shfl_xor(mx, o));
            const float ex = expf(v - mx); float sum = ex;
#pragma unroll
            for (int o = 4; o < 64; o <<= 1) sum += __shfl_xor(sum, o);
            if ((q ? vb : va) && (lane & 3) == 0) F.AFF()[((size_t)(q ? bb : ba) * 16 + (lane >> 2)) * TPB + (q ? tb : ta)] = ex / sum;
        }
    }
    __syncthreads();
}

__device__ __forceinline__ void ph_router(const Params& p, const Frame& F0, int l) { const Frame F = fresh(F0);
    const int lane = F.lane, tid = F.tid, wid = F.wid, t16 = lane & 15, kq = lane >> 4; const bool need_ctx = (l + 1 < NLAYER);
    LAS float* WRm = (LAS float*)F.lds; LAS float* PART = WRm + 32768; LAS float* SSP = PART + 2 * 2048; LAS float* CC = SSP + 2 * 128;
    const float* wr = p.w_router + (size_t)l * 2048 * 16;
    { const int e = tid & 15, part = tid >> 4; float ac[9];
#pragma unroll
      for (int m = 0; m < 9; ++m) ac[m] = 0.f;
      const float* shb = F.MOD() + (size_t)l * 9 * 12288 + 3 * 2048;
#pragma unroll 8
      for (int dd = 0; dd < 64; ++dd) { const int d = part * 64 + dd; const float wv = wr[d * 16 + e];
#pragma unroll
          for (int m = 0; m < 9; ++m) ac[m] += shb[(size_t)m * 12288 + d] * wv; }
#pragma unroll
      for (int m = 0; m < 9; ++m) WRm[(m * 32 + part) * 16 + e] = ac[m];
      __syncthreads();
      if (tid < 144) { const int m = tid >> 4, e2 = tid & 15; float sum = 0.f;
#pragma unroll
          for (int q = 0; q < 32; ++q) sum += WRm[(m * 32 + q) * 16 + e2];
          CC[tid] = sum; }
      __syncthreads(); }
    { const f32x4* w4 = (const f32x4*)wr;
      f32x4 wv[16];
#pragma unroll
      for (int k = 0; k < 16; ++k) wv[k] = w4[tid + k * 512];
#pragma unroll
      for (int k = 0; k < 16; ++k) { const int i4 = tid + k * 512, d = i4 >> 2, e0 = (i4 & 3) * 4;
          const int base = (((d >> 8) * 16 + ((d >> 4) & 15)) * 64 + ((d >> 2) & 3) * 16) * 4 + (d & 3);
#pragma unroll
          for (int j = 0; j < 4; ++j) WRm[base + (e0 + j) * 4] = wv[k][j]; } }
    __syncthreads();
    const float* nwl = p.norm2 + (size_t)l * DM + 256 * wid + 4 * kq;
    const LAS float* bl = WRm + (wid * 16) * 256 + lane * 4;
    const int ngl = need_ctx ? NTOK / 16 : (NTOK / 16) - NB * 16;
    const int k0 = (int)(((long)F.bid * ngl) / F.G), k1 = (int)(((long)(F.bid + 1) * ngl) / F.G);
#define RT_GRP(k) (need_ctx ? (k) : ((k) >> 7) * 144 + 16 + ((k) & 127))
    int kk = k0; int g = (kk < k1) ? RT_GRP(kk) : NTOK / 16;
    f32x4 xq[16], xn[16];
    if (g < NTOK / 16) { const float* xrow = F.X() + (size_t)(g * 16 + t16) * DM + 256 * wid + 4 * kq;
#pragma unroll
        for (int j = 0; j < 16; ++j) xq[j] = *(const f32x4*)(xrow + 16 * j); }
    int buf = 0;
    while (g < NTOK / 16) {
        ++kk; const int gn = (kk < k1) ? RT_GRP(kk) : NTOK / 16;
        if (gn < NTOK / 16) { const float* xrow = F.X() + (size_t)(gn * 16 + t16) * DM + 256 * wid + 4 * kq;
#pragma unroll
            for (int j = 0; j < 16; ++j) xn[j] = *(const f32x4*)(xrow + 16 * j); }
        const int row0 = g * 16, b = row0 / TPB, t0 = row0 % TPB; const int mr = (t0 < 256) ? 8 : b;
        const float* md = F.MOD() + ((size_t)l * 9 + mr) * 12288 + 256 * wid + 4 * kq;
        LAS float* PB = PART + buf * 2048; LAS float* SB = SSP + buf * 128;
        f32x4 acc = (f32x4){0.f, 0.f, 0.f, 0.f}; float ss = 0.f;
#pragma unroll
        for (int j = 0; j < 16; ++j) {
            const f32x4 g4 = *(const f32x4*)(nwl + 16 * j), sc4 = *(const f32x4*)(md + 4 * 2048 + 16 * j);
            const f32x4 bq = *(const LAS f32x4*)(bl + j * 256);
            ss += (xq[j][0] * xq[j][0] + xq[j][1] * xq[j][1]) + (xq[j][2] * xq[j][2] + xq[j][3] * xq[j][3]);
            xq[j] = xq[j] * (g4 * (sc4 + 1.0f));
#pragma unroll
            for (int c = 0; c < 4; ++c) acc = __builtin_amdgcn_mfma_f32_16x16x4f32(xq[j][c], bq[c], acc, 0, 0, 0);
        }
        ss += __shfl_xor(ss, 16); ss += __shfl_xor(ss, 32);
#pragma unroll
        for (int r = 0; r < 4; ++r) PB[(wid * 16 + 4 * kq + r) * 16 + t16] = acc[r];
        if (kq == 0) SB[wid * 16 + t16] = ss;
        __syncthreads();
        float sst = 0.f;
#pragma unroll
        for (int w = 0; w < 8; ++w) sst += SB[w * 16 + t16];
        const float rstd = 1.0f / sqrtf(sst * (1.0f / DM) + EPSN);
        {
            const int tok = 2 * wid + (kq & 1); float lgv = 0.f, s2 = 0.f;
#pragma unroll
            for (int w = 0; w < 8; ++w) { lgv += PB[(w * 16 + tok) * 16 + t16]; s2 += SB[w * 16 + tok]; }
            lgv = lgv * (1.0f / sqrtf(s2 * (1.0f / DM) + EPSN)) + CC[mr * 16 + t16];
            float mx = lgv;
#pragma unroll
            for (int o = 1; o < 16; o <<= 1) mx = fmaxf(mx, __shfl_xor(mx, o));
            const float ex = expf(lgv - mx); float sum = ex;
#pragma unroll
            for (int o = 1; o < 16; o <<= 1) sum += __shfl_xor(sum, o);
            if (lane < 32) F.AFF()[((size_t)b * 16 + t16) * TPB + t0 + tok] = ex / sum;
        }
        bf16_t* hrow = F.H() + (size_t)(row0 + t16) * DM + 256 * wid + 4 * kq;
#pragma unroll
        for (int j = 0; j < 16; ++j) { const f32x4 sh4 = *(const f32x4*)(md + 3 * 2048 + 16 * j); const f32x4 hv = xq[j] * rstd + sh4;
            u32x2 w; w.x = cvt_pk_bf16(hv[0], hv[1]); w.y = cvt_pk_bf16(hv[2], hv[3]); *(u32x2*)(hrow + 16 * j) = w; }
#pragma unroll
        for (int j = 0; j < 16; ++j) xq[j] = xn[j];
        g = gn; buf ^= 1;
    }
#undef RT_GRP
    __syncthreads();
}

__device__ __forceinline__ int block_scan(int v, LAS int* tmp, int tid, int lane, int wid, int* tot) {
    int inc = v;
#pragma unroll
    for (int o = 1; o < 64; o <<= 1) { const int t = __shfl_up(inc, o); if (lane >= o) inc += t; }
    __syncthreads();
    if (lane == 63) tmp[wid] = inc;
    __syncthreads();
    int base = 0, total = 0;
#pragma unroll
    for (int w = 0; w < 8; ++w) { const int c = tmp[w]; if (w < wid) base += c; total += c; }
    *tot = total;
    return base + inc - v;
}
__device__ __forceinline__ void ph_topk(const Params& p, const Frame& F0, int l) { const Frame F = fresh(F0);
    const int tid = F.tid, lane = F.lane, wid = F.wid; const bool need_ctx = (l + 1 < NLAYER);
    const int RPB = need_ctx ? 288 : 256, RPE = 8 * RPB, nprob = need_ctx ? 256 : 128;
    LAS unsigned* keys = (LAS unsigned*)F.lds; LAS unsigned* hist = keys + 2048; LAS int* tmp = (LAS int*)(hist + 8 * 256); LAS unsigned* sel = (LAS unsigned*)(tmp + 16);
    for (int pr = F.bid; pr < nprob; pr += F.G) {
        const int seg = pr >> 7, be = pr & 127, b = be >> 4, e = be & 15;
        const int n = seg ? 256 : 2048, off = seg ? 0 : 256, cap = seg ? 32 : 256;
        const float* a = F.AFF() + ((size_t)b * 16 + e) * TPB + off;
        __syncthreads();
        for (int i = tid; i < n; i += 512) keys[i] = __float_as_uint(a[i]);
        unsigned prefix = 0u, mask = 0u; int remaining = cap;
        for (int pass = 0; pass < 4; ++pass) {
            const int shift = 24 - 8 * pass;
            for (int i = tid; i < 8 * 256; i += 512) hist[i] = 0u;
            __syncthreads();
            for (int i = tid; i < n; i += 512) { const unsigned k = keys[i]; if ((k & mask) == prefix) __hip_atomic_fetch_add(&hist[wid * 256 + ((k >> shift) & 255u)], 1u, __ATOMIC_RELAXED, __HIP_MEMORY_SCOPE_WORKGROUP); }
            __syncthreads();
            int hv = 0;
            if (tid < 256) { const int bin = 255 - tid;
#pragma unroll
                for (int w = 0; w < 8; ++w) hv += (int)hist[w * 256 + bin]; }
            int tot; const int gt = block_scan(hv, tmp, tid, lane, wid, &tot);
            if (tid < 256 && hv > 0 && gt < remaining && remaining <= gt + hv) { sel[0] = (unsigned)(255 - tid); sel[1] = (unsigned)(remaining - gt); }
            __syncthreads();
            prefix |= sel[0] << shift; mask |= 255u << shift; remaining = (int)sel[1];
            __syncthreads();
        }
        const int per = n / 512 > 0 ? n / 512 : 1;
        const int i0 = tid * per; const bool actv = i0 < n;
        unsigned kk[4]; int eqc = 0;
#pragma unroll
        for (int j = 0; j < 4; ++j) { kk[j] = (actv && j < per) ? keys[i0 + j] : 0u; if (actv && j < per && kk[j] == prefix) ++eqc; }
        int tot; const int eqbase = block_scan(eqc, tmp, tid, lane, wid, &tot);
        int selc = 0, er = eqbase; bool sl[4];
#pragma unroll
        for (int j = 0; j < 4; ++j) { sl[j] = false; if (actv && j < per) { if (kk[j] > prefix) sl[j] = true; else if (kk[j] == prefix) { sl[j] = er < remaining; ++er; } } if (sl[j]) ++selc; }
        int rank = block_scan(selc, tmp, tid, lane, wid, &tot);
#pragma unroll
        for (int j = 0; j < 4; ++j) if (actv && j < per) {
            const int tok = b * TPB + off + i0 + j; int slot = -1;
            if (sl[j]) { slot = e * RPE + b * RPB + (seg ? 256 : 0) + rank; ++rank; F.PTOK()[slot] = tok; F.PGV()[slot] = __uint_as_float(kk[j]); }
            F.TOKSLOT()[(size_t)tok * 16 + e] = slot; }
    }
    if (!need_ctx && F.G == 256 && F.bid >= 128 && CVT_TKQ > 0) { const int w = F.bid - 128;
        if (w < 2 * CVT_TKQ) { __syncthreads(); cvt_item(p, F, CVT_D0 - CVT_MQ1 - CVT_TKQ + (w >> 1), w & 1); } }
    __syncthreads();
}

__device__ __forceinline__ void ph_gather(const Frame& F0, int l) { const Frame F = fresh(F0);
    const int lane = F.lane; const int npair = (l + 1 < NLAYER) ? 36864 : 32768;
    for (int pr = F.bid * 8 + F.wid; pr < npair; pr += F.G * 8) {
        const int tok = F.PTOK()[pr];
        const u32x4* src = (const u32x4*)(F.H() + (size_t)tok * DM); u32x4* dst = (u32x4*)(F.XG() + (size_t)pr * DM);
        const u32x4 a = src[lane], b2 = src[64 + lane], c = src[128 + lane], d = src[192 + lane];
        dst[lane] = a; dst[64 + lane] = b2; dst[128 + lane] = c; dst[192 + lane] = d;
    }
}
#ifndef DIS
#define DIS 0
#endif
#ifndef MK_PER_PHASE
#define MK_PER_PHASE 0
#endif
constexpr int NPH_LAYER = 13, NPHASE = 2 + NLAYER * NPH_LAYER;

__global__ void __launch_bounds__(512, 2) mk_fwd(Params p) {
    extern __shared__ __attribute__((aligned(16))) unsigned char lds_raw[];
    Frame F;
    F.lds = (LAS unsigned char*)lds_raw; F.ws = (__attribute__((address_space(1))) unsigned char*)p.ws;
    F.tid = threadIdx.x; F.lane = F.tid & 63; F.wid = __builtin_amdgcn_readfirstlane(F.tid >> 6); F.bid = blockIdx.x; F.G = gridDim.x;
    F.vcu = (F.G % 8 == 0) ? (F.bid % 8) * (F.G / 8) + F.bid / 8 : F.bid;

    if (F.tid < 16) ((LAS unsigned*)(F.lds + LDS_MISC))[F.tid] = 0u;
    __syncthreads();
#if MK_PER_PHASE
#define GRID_BAR() do { } while (0)
#else
    XcdBarrier bar = xcd_barrier_post(F.ctl(), (volatile LAS unsigned*)(F.lds + LDS_MISC));
#define GRID_BAR() xcd_barrier(bar)
#endif
    const int lo = p.ph_lo, hi = p.ph_hi;
#define IN(k) (lo <= (k) && (k) < hi)
#define SEAM(k) do { if (IN(k) && IN((k) + 1)) GRID_BAR(); } while (0)

    if (!(DIS & 1) && IN(0)) { ph_prologue(p, F); if (REP & 1) { __syncthreads(); ph_prologue(p, F); } }
    SEAM(0);
    for (int l = 0; l < NLAYER; ++l) {
        const int pb = 1 + l * NPH_LAYER;
        const bool need_ctx = (l + 1 < NLAYER);
        if (!(DIS & (1 << 1)) && IN(pb + 0)) { ph_norm1(p, F, l, l == 0 ? 0 : 1); if ((REP & 2) && l == 0) { __syncthreads(); ph_norm1(p, F, l, 0); } }
        SEAM(pb + 0);
        if (!(DIS & (1 << 2)) && IN(pb + 1)) for (int rep = 0; rep < (((REP >> 2) & 1) + 1); ++rep) { if (rep) __syncthreads();
            pg8::Gemm g{F.H(), F.WIN() + (size_t)l * NPW * 2048, NTOK, NPW, 2048};
            EpiInProj E{F.P(), F.PG()};
            const bool split = (F.G == 256) && (SIDE_MASK & (need_ctx ? 1 : 8)); const int xcd = F.bid & 7, lid = F.bid >> 3;
            if (need_ctx) {
                const int ngx = 27;
                if (!split || lid < ngx) { TileOrder S; if (!split) S.init(72, 18, F.G, F.vcu, 0); else S.init(72, 18, 8 * ngx, xcd * ngx + lid, 0);
                    pg8::gemm_phase<EpiInProj, TileOrder, true, true>(F.lds, g, S, E); }
                else ph_convert_side(p, F, ngx, CVT_A0, CVT_A1);
            } else {
                const int ngx = 31;
                if (!split || lid < ngx) { InProjLastOrder S; if (!split) S.init(F.G, F.vcu); else S.init(8 * ngx, xcd * ngx + lid);
                    pg8::gemm_phase<EpiInProj, InProjLastOrder, true, true>(F.lds, g, S, E); }
                else ph_convert_side(p, F, ngx, CVT_D0, CVT_D1);
            }
        }
        SEAM(pb + 1);
        if (!(DIS & (1 << 3)) && IN(pb + 2)) for (int rep = 0; rep < (((REP >> 3) & 1) + 1); ++rep) { if (rep) __syncthreads(); ph_prep(p, F, l); }
        SEAM(pb + 2);
        if (!(DIS & (1 << 4)) && IN(pb + 3)) for (int rep = 0; rep < (((REP >> 4) & 1) + 1); ++rep) { if (rep) __syncthreads();
            { pg8::Gemm g{F.QA(), F.WUQ() + (size_t)l * 768 * 512, NTOK, 768, 512}; TileOrder S; S.init(72, 3, F.G, F.vcu, 0);
              EpiBf16Store E{F.MQ(), 768};
              pg8::gemm_phase<EpiBf16Store, TileOrder, true, true>(F.lds, g, S, E); }
            __syncthreads();
            { pg8::Gemm g{F.KVA(), F.WUKV() + (size_t)l * 1024 * 256, NTOK, 1024, 256}; TileOrder S; S.init(72, 4, F.G, (F.vcu + 216) % F.G, 0);
              EpiBf16Store E{F.MKV(), 1024};
              pg8::gemm_phase<EpiBf16Store, TileOrder, true, true>(F.lds, g, S, E); }
        }
        SEAM(pb + 3);
        if (!MP_IN_MIXER) { if (!(DIS & (1 << 5)) && IN(pb + 4)) for (int rep = 0; rep < (((REP >> 5) & 1) + 1); ++rep) { if (rep) __syncthreads(); ph_mla_prep(p, F, l); }
            SEAM(pb + 4); }
        if (!(DIS & (1 << 6)) && IN(pb + 5)) { ph_mixer(p, F, l, 0, REP >> 16); if (REP & 0x40) { __syncthreads(); ph_mixer(p, F, l, 1, REP >> 16); } }
        SEAM(pb + 5);
        if (!MO_IN_MIXER) { if (!(DIS & (1 << 7)) && IN(pb + 6)) for (int rep = 0; rep < (((REP >> 7) & 1) + 1); ++rep) { if (rep) __syncthreads(); ph_mlstm_out(p, F, l); }
            SEAM(pb + 6); }
        if (!(DIS & (1 << 8)) && IN(pb + 7)) {
            pg8::Gemm g{F.MIX(), F.WOUT() + (size_t)l * 2048 * 2048, NTOK, 2048, 2048};
            EpiOutProj E{F.X(), F.MOD() + (size_t)l * 9 * 12288 + 2 * 2048, need_ctx ? p.x : nullptr, p.ctx};
            const bool split = (F.G == 256) && need_ctx && (SIDE_MASK & 2); const int xcd = F.bid & 7, lid = F.bid >> 3, ngx = 24;
            if (!split || lid < ngx) { TileOrder S; if (!split) S.init(need_ctx ? 72 : 64, 8, F.G, F.vcu, need_ctx ? 0 : 1); else S.init(72, 8, 8 * ngx, xcd * ngx + lid, 0);
                pg8::gemm_phase<EpiOutProj, TileOrder, true, true>(F.lds, g, S, E); }
            else ph_convert_side(p, F, ngx, CVT_B0, CVT_B1);
        }
        SEAM(pb + 7);
        if (!(DIS & (1 << 9)) && IN(pb + 8)) for (int rep = 0; rep < (((REP >> 9) & 1) + 1); ++rep) { if (rep) __syncthreads(); if (ROUTER_MFMA) ph_router(p, F, l); else ph_router_valu(p, F, l); }
        SEAM(pb + 8);
        if (!(DIS & (1 << 10)) && IN(pb + 9)) for (int rep = 0; rep < (((REP >> 10) & 1) + 1); ++rep) { if (rep) __syncthreads(); ph_topk(p, F, l); }
        SEAM(pb + 9);
        if (!(DIS & (1 << 11)) && IN(pb + 10)) for (int rep = 0; rep < (((REP >> 11) & 1) + 1); ++rep) { if (rep) __syncthreads(); if (USE_GATHER_PHASE) ph_gather(F, l); }
        if (USE_GATHER_PHASE) SEAM(pb + 10);
        const int RT = need_ctx ? 9 : 8;
        if (!(DIS & (1 << 12)) && IN(pb + 11)) for (int rep = 0; rep < (((REP >> 12) & 1) + 1); ++rep) { if (rep) __syncthreads();
            pg8::Gemm g{F.H(), F.WGU() + (size_t)l * 16 * 4096 * 2048, NEXP * RT * 256, NEXP * 4096, 2048, F.PTOK()}; MoeOrder S; S.init(RT, 16, F.G, F.vcu);
            EpiSwiGLU E{F.ACT(), 16};
            pg8::gemm_phase<EpiSwiGLU, MoeOrder, true, true, true, MOE_BAUX>(F.lds, g, S, E);
        }
        SEAM(pb + 11);
        if (!(DIS & (1 << 13)) && IN(pb + 12)) for (int rep = 0; rep < (((REP >> 13) & 1) + 1); ++rep) { if (rep) __syncthreads();
            pg8::Gemm g{F.ACT(), F.WD() + (size_t)l * 16 * 2048 * 2048, NEXP * RT * 256, NEXP * 2048, 2048};
            EpiDown E{F.Y(), F.PGV(), 8};
            const bool split = (F.G == 256) && need_ctx && (SIDE_MASK & 4); const int xcd = F.bid & 7, lid = F.bid >> 3, ngx = 29;
            if (!split || lid < ngx) { MoeOrder S; if (!split) S.init(RT, 8, F.G, F.vcu); else S.init(RT, 8, 8 * ngx, xcd * ngx + lid);
                pg8::gemm_phase<EpiDown, MoeOrder, true, true, false, MOE_BAUX>(F.lds, g, S, E); }
            else ph_convert_side(p, F, ngx, CVT_C0, CVT_C1);
        }
        SEAM(pb + 12);
    }
    if (!(DIS & (1 << 14)) && IN(NPHASE - 1)) { ph_norm1(p, F, NLAYER - 1, 2); }
#undef IN
#undef SEAM
#undef GRID_BAR
}

extern "C" void kernel_launch(void* const* d_in, const int* in_sizes, int n_in, void* d_out, int out_size, void* d_ws, size_t ws_size, hipStream_t stream) {
    static int grid = 0;
    if (grid == 0) {
        if (n_in != 24 || out_size != NB * 2048 * DM || ws_size < WS_END) {
            fprintf(stderr, "kernel_launch: built for 24 inputs, %d outputs, >= %zu workspace bytes; got n_in %d out %d ws %zu\n", NB * 2048 * DM, (size_t)WS_END, n_in, out_size, ws_size); grid = -1; return; }
        int dev = 0, cus = 0, per_cu = 0;
        if (hipGetDevice(&dev) != hipSuccess || hipDeviceGetAttribute(&cus, hipDeviceAttributeMultiprocessorCount, dev) != hipSuccess) { fprintf(stderr, "kernel_launch: device query failed\n"); grid = -1; return; }
        if (hipFuncSetAttribute((const void*)mk_fwd, hipFuncAttributeMaxDynamicSharedMemorySize, LDS_BYTES) != hipSuccess) { fprintf(stderr, "kernel_launch: hipFuncSetAttribute(%d) failed\n", LDS_BYTES); grid = -1; return; }
        if (hipOccupancyMaxActiveBlocksPerMultiprocessor(&per_cu, (const void*)mk_fwd, 512, LDS_BYTES) != hipSuccess || per_cu < 1)
            fprintf(stderr, "kernel_launch: note: occupancy query reports %d workgroups per CU\n", per_cu);
        (void)hipGetLastError();
        grid = cus;
        if (grid % 8 != 0 || grid < 64) fprintf(stderr, "kernel_launch: unexpected CU count %d\n", grid);
    }
    if (grid < 0) return;
    if (hipMemsetAsync((char*)d_ws + WS_CTL, 0, CTL_BYTES, stream) != hipSuccess) { fprintf(stderr, "kernel_launch: memset failed\n"); return; }
    Params p{};
    const float** pp = (const float**)&p;
    for (int i = 0; i < 24; ++i) pp[i] = (const float*)d_in[i];
    p.out = (float*)d_out; p.ws = (unsigned char*)d_ws;
#if MK_PER_PHASE
    for (int k = 0; k < NPHASE; ++k) { p.ph_lo = k; p.ph_hi = k + 1; hipLaunchKernelGGL(mk_fwd, dim3(grid), dim3(512), LDS_BYTES, stream, p); }
#else
    p.ph_lo = 0; p.ph_hi = NPHASE;
    hipLaunchKernelGGL(mk_fwd, dim3(grid), dim3(512), LDS_BYTES, stream, p);
#endif
    const hipError_t le = hipPeekAtLastError();
    if (le != hipSuccess) fprintf(stderr, "kernel_launch: launch failed: %s\n", hipGetErrorName(le));
}
```
